# Optimizing an MI355X kernel written in HIP

```python
import math
import jax, jax.numpy as jnp
from jax import lax
import numpy as np

D_MODEL = 2048
BATCH = 1
SEQ = 8192
DEPTH = 4

MIX_WIDTH = D_MODEL
FOURIER_WIDTH = D_MODEL // 2
N_FOURIER_GROUPS = 8
FOURIER_GROUP_DIM = FOURIER_WIDTH // N_FOURIER_GROUPS
ATTN_WIDTH = MIX_WIDTH - FOURIER_WIDTH
N_HEADS = 8
V_HEAD_DIM = ATTN_WIDTH // N_HEADS
QK_HEAD_DIM = V_HEAD_DIM // 2
IN_WIDTH = FOURIER_WIDTH + 3 * ATTN_WIDTH
D_FF = 5632
ROPE_THETA = 10000.0
Q_BLOCK = 128
NORM_EPS = 1e-6
SUBLN_EPS = 1e-5
LAMBDA_STD = 0.1

kernel_name = "hybrid_fourier_diffattn_macaron_encoder"


def _rmsnorm(x, g, eps=NORM_EPS):
    xf = x.astype(jnp.float32)
    y = xf * lax.rsqrt(jnp.mean(xf * xf, axis=-1, keepdims=True) + eps)
    return (y * g.astype(jnp.float32)).astype(x.dtype)


def _swiglu(h, w_gate, w_up, w_down):
    return (jax.nn.silu(h @ w_gate) * (h @ w_up)) @ w_down


def _rope_tables(positions):
    inv_freq = 1.0 / (ROPE_THETA ** (jnp.arange(0, QK_HEAD_DIM, 2, dtype=jnp.float32) / QK_HEAD_DIM))
    ang = positions.astype(jnp.float32)[..., None] * inv_freq
    ang = jnp.concatenate([ang, ang], axis=-1)
    return jnp.cos(ang), jnp.sin(ang)


def _rope(t, cos, sin):
    tf = t.astype(jnp.float32)
    c = cos[:, :, None, None, :]
    s = sin[:, :, None, None, :]
    half = QK_HEAD_DIM // 2
    rot = jnp.concatenate([-tf[..., half:], tf[..., :half]], axis=-1)
    return tf * c + rot * s


def _fourier_mix(u):
    b, s, _ = u.shape
    ug = u.reshape(b, s, N_FOURIER_GROUPS, FOURIER_GROUP_DIM).astype(jnp.float32)
    y = jnp.fft.fft2(ug, axes=(1, 3), norm="ortho").real
    return y.reshape(b, s, FOURIER_WIDTH).astype(u.dtype)


def _diff_attention(q, k, v, cos, sin, g_q, g_k, lq1, lk1, lq2, lk2, g_sub, layer_idx):
    b, s, _ = q.shape
    q = q.reshape(b, s, N_HEADS, 2, QK_HEAD_DIM)
    k = k.reshape(b, s, N_HEADS, 2, QK_HEAD_DIM)
    v = v.reshape(b, s, N_HEADS, V_HEAD_DIM)
    scale = QK_HEAD_DIM ** -0.5
    q = _rope(_rmsnorm(q, g_q), cos, sin) * scale
    k = _rope(_rmsnorm(k, g_k), cos, sin)
    vf = v.astype(jnp.float32)

    lambda_init = 0.8 - 0.6 * math.exp(-0.3 * layer_idx)
    lam = (jnp.exp(jnp.sum(lq1.astype(jnp.float32) * lk1.astype(jnp.float32)))
           - jnp.exp(jnp.sum(lq2.astype(jnp.float32) * lk2.astype(jnp.float32)))
           + lambda_init)

    n_blocks = s // Q_BLOCK
    qb = q.reshape(b, n_blocks, Q_BLOCK, N_HEADS, 2, QK_HEAD_DIM).transpose(1, 0, 2, 3, 4, 5)

    def block(q_blk):
        scores = jnp.einsum('bqhcd,bkhcd->bhcqk', q_blk, k)
        p = jax.nn.softmax(scores, axis=-1)
        a = p[:, :, 0] - lam * p[:, :, 1]
        return jnp.einsum('bhqk,bkhd->bqhd', a, vf)

    o = lax.map(block, qb)
    o = o.transpose(1, 0, 2, 3, 4).reshape(b, s, N_HEADS, V_HEAD_DIM)
    o = _rmsnorm(o, g_sub, SUBLN_EPS) * (1.0 - lambda_init)
    return o.reshape(b, s, ATTN_WIDTH).astype(v.dtype)


def setup_inputs(seed: int = 0) -> dict:
    key = jax.random.key(seed)
    ks = jax.random.split(key, 24)
    f32 = jnp.float32

    def w(k, shape, fan_in):
        return jax.random.normal(k, shape, f32) * (fan_in ** -0.5)

    def gain(k, shape):
        return 1.0 + 0.02 * jax.random.normal(k, shape, f32)

    x = jax.random.normal(ks[0], (BATCH, SEQ, D_MODEL), f32)
    positions = jnp.broadcast_to(jnp.arange(SEQ, dtype=jnp.int32)[None, :], (BATCH, SEQ))
    return {
        "x": x,
        "positions": positions,
        "norm_ffn1": gain(ks[1], (DEPTH, D_MODEL)),
        "w1_gate": w(ks[2], (DEPTH, D_MODEL, D_FF), D_MODEL),
        "w1_up": w(ks[3], (DEPTH, D_MODEL, D_FF), D_MODEL),
        "w1_down": w(ks[4], (DEPTH, D_FF, D_MODEL), D_FF),
        "norm_mix": gain(ks[5], (DEPTH, D_MODEL)),
        "w_in": w(ks[6], (DEPTH, D_MODEL, IN_WIDTH), D_MODEL),
        "q_norm": gain(ks[7], (DEPTH, QK_HEAD_DIM)),
        "k_norm": gain(ks[8], (DEPTH, QK_HEAD_DIM)),
        "lambda_q1": LAMBDA_STD * jax.random.normal(ks[9], (DEPTH, QK_HEAD_DIM), f32),
        "lambda_k1": LAMBDA_STD * jax.random.normal(ks[10], (DEPTH, QK_HEAD_DIM), f32),
        "lambda_q2": LAMBDA_STD * jax.random.normal(ks[11], (DEPTH, QK_HEAD_DIM), f32),
        "lambda_k2": LAMBDA_STD * jax.random.normal(ks[12], (DEPTH, QK_HEAD_DIM), f32),
        "subln": gain(ks[13], (DEPTH, V_HEAD_DIM)),
        "w_out": w(ks[14], (DEPTH, MIX_WIDTH, D_MODEL), MIX_WIDTH),
        "norm_ffn2": gain(ks[15], (DEPTH, D_MODEL)),
        "w2_gate": w(ks[16], (DEPTH, D_MODEL, D_FF), D_MODEL),
        "w2_up": w(ks[17], (DEPTH, D_MODEL, D_FF), D_MODEL),
        "w2_down": w(ks[18], (DEPTH, D_FF, D_MODEL), D_FF),
    }


def reference(x, positions, norm_ffn1, w1_gate, w1_up, w1_down, norm_mix, w_in,
              q_norm, k_norm, lambda_q1, lambda_k1, lambda_q2, lambda_k2, subln,
              w_out, norm_ffn2, w2_gate, w2_up, w2_down):
    cos, sin = _rope_tables(positions)
    split_at = [FOURIER_WIDTH, FOURIER_WIDTH + ATTN_WIDTH, FOURIER_WIDTH + 2 * ATTN_WIDTH]
    for l in range(DEPTH):
        x = x + 0.5 * _swiglu(_rmsnorm(x, norm_ffn1[l]), w1_gate[l], w1_up[l], w1_down[l])
        h = _rmsnorm(x, norm_mix[l])
        proj = h @ w_in[l]
        u_f, q, k, v = jnp.split(proj, split_at, axis=-1)
        y_f = _fourier_mix(u_f)
        y_a = _diff_attention(q, k, v, cos, sin, q_norm[l], k_norm[l],
                              lambda_q1[l], lambda_k1[l], lambda_q2[l], lambda_k2[l],
                              subln[l], l)
        x = x + jnp.concatenate([y_f, y_a], axis=-1) @ w_out[l]
        x = x + 0.5 * _swiglu(_rmsnorm(x, norm_ffn2[l]), w2_gate[l], w2_up[l], w2_down[l])
    return x
```

```cpp
#include <hip/hip_runtime.h>
#include <cstdio>
#include <cstdint>
#include <cmath>
namespace pg8 {
#define PG8_LAS __attribute__((address_space(3)))
typedef unsigned short bf16_t;
typedef short bf16x8 __attribute__((ext_vector_type(8)));
typedef float f32x4 __attribute__((ext_vector_type(4)));
typedef unsigned u32x4 __attribute__((ext_vector_type(4)));
typedef unsigned u32x2 __attribute__((ext_vector_type(2)));
constexpr int BM = 256, BK = 64, HALF = 128, HTB = HALF * BK * 2  , STAGE_BYTES = 8 * HTB, NXCD = 8, WGM = 8;

__host__ __device__ __forceinline__ int lds_byte(int r, int c) { const int st = (r >> 4) * 2 + (c >> 5), rr = r & 15, cc = c & 31, ob = rr * 64 + cc * 2; return st * 1024 + (ob ^ (((ob >> 9) & 1) << 5)); }
__host__ __device__ __forceinline__ void stage_rc(int b, int& R, int& C) { const int st = b / 1024, sb = b % 1024, swz = sb ^ (((sb >> 9) & 1) << 5); R = (st >> 1) * 16 + swz / 64; C = (st & 1) * 32 + (swz % 64) / 2; }
__host__ __device__ __forceinline__ int perm32(int rho) { const int n = rho >> 4, i = rho & 15; return 8 * (i >> 2) + 4 * n + (i & 3); }

struct Unit { int pm, pn; };
struct Gemm { const bf16_t* A; const bf16_t* Bt; int M, N, K, lda, ldb; };

struct StaticOrder {
    int nM, nN, nwg, G, c, wgm, nlim;
    __host__ __device__ void init(int M, int N, int G_, int c_, int wgm_ = WGM) { nM = M / BM; nN = N / BM; nwg = nM * nN; G = G_; c = c_; wgm = wgm_; nlim = nwg; }
    __host__ __device__ void unit_of(int L, Unit& u) const {
        int wgid = L; { const int q = nwg / NXCD, r = nwg % NXCD, xcd = wgid % NXCD, off = wgid / NXCD; wgid = (xcd < r ? xcd * (q + 1) : r * (q + 1) + (xcd - r) * q) + off; }
        const int nig = wgm * nN, gid = wgid / nig, fm = gid * wgm, gsz = (nM - fm) < wgm ? (nM - fm) : wgm;
        u.pm = fm + ((wgid % nig) % gsz); u.pn = (wgid % nig) / gsz;
    }
    __host__ __device__ bool next(int i, Unit& u) const {
        const long L = (long)i * G + c; if (L >= nlim) return false;
        unit_of((int)L, u); return true;
    }
    __device__ __forceinline__ void a_ready(const Unit&) const {}
    __device__ __forceinline__ void done(const Unit&) const {}
};
struct TailHalves {
    StaticOrder S; int first;
    __host__ __device__ bool next(int i, Unit& u) const { const int ntail = S.nwg - first; const long j = (long)i * S.G + S.c; if (j >= 2 * ntail) return false;
        S.unit_of(first + (int)(j % ntail), u); u.pm = 2 * u.pm + (int)(j / ntail); return true; }
    __device__ __forceinline__ void a_ready(const Unit&) const {}
    __device__ __forceinline__ void done(const Unit&) const {}
};
struct OneRound {
    StaticOrder S; int r;
    __host__ __device__ bool next(int i, Unit& u) const { return i == 0 && S.next(r, u); }
    __device__ __forceinline__ void a_ready(const Unit&) const {}
    __device__ __forceinline__ void done(const Unit&) const {}
};

__device__ __forceinline__ unsigned cvt_pk_bf16(float lo, float hi) { unsigned r; asm volatile("v_cvt_pk_bf16_f32 %0, %1, %2" : "=v"(r) : "v"(lo), "v"(hi)); return r; }
typedef float f32x2 __attribute__((ext_vector_type(2)));
template <int CTRL> __device__ __forceinline__ float dpp_f(float v) { return __builtin_bit_cast(float, __builtin_amdgcn_update_dpp(0, __builtin_bit_cast(int, v), CTRL, 0xF, 0xF, true)); }
__device__ __forceinline__ float sum8(float v) { v += dpp_f<0xB1>(v); v += dpp_f<0x4E>(v); v += dpp_f<0x141>(v); return v; }
__device__ __forceinline__ float sum_xor16(float v) { float a = v, b = v; asm volatile("s_nop 1\n\tv_permlane16_swap_b32 %0, %1" : "+v"(a), "+v"(b)); return a + b; }
__device__ __forceinline__ float sum_xor32(float v) { float a = v, b = v; asm volatile("s_nop 1\n\tv_permlane32_swap_b32 %0, %1" : "+v"(a), "+v"(b)); return a + b; }
__device__ __forceinline__ float sum_fq(float s) { return sum_xor32(sum_xor16(s)); }
__device__ __forceinline__ int opaque0() { int z; asm volatile("v_mov_b32 %0, 0" : "=v"(z)); return z; }
template <bool TOK = false> __device__ __forceinline__ void rows_rstd(float (&rs)[8], const float* ssq, int row0, int fq) {
    f32x4 pa[8], pb[8];
#pragma unroll
    for (int i = 0; i < 8; ++i) { const f32x4* p = (const f32x4*)(ssq + (size_t)(TOK ? row0 + 64 * i : row0 + (i >> 2) * HALF + (i & 3) * 16) * 32 + fq * 8); pa[i] = p[0]; pb[i] = p[1]; }
    __builtin_amdgcn_sched_barrier(0);
#pragma unroll
    for (int i = 0; i < 8; ++i) { const f32x4 a = pa[i], b = pb[i]; float s = ((a[0] + a[1]) + (a[2] + a[3])) + ((b[0] + b[1]) + (b[2] + b[3])); s = sum_fq(s); rs[i] = 1.0f / sqrtf(s * (1.0f / 2048.0f) + 1e-6f); }
}
__device__ __forceinline__ float row_rstd(const float* ssq, int row) {
    const f32x4* p = (const f32x4*)(ssq + (size_t)row * 32); f32x4 v[8];
#pragma unroll
    for (int i = 0; i < 8; ++i) v[i] = p[i];
    float s = 0.f;
#pragma unroll
    for (int i = 0; i < 8; ++i) s += (v[i][0] + v[i][1]) + (v[i][2] + v[i][3]);
    return 1.0f / sqrtf(s * (1.0f / 2048.0f) + 1e-6f);
}
__device__ __forceinline__ float silu_mul(float g, float u) { const float e = __builtin_amdgcn_exp2f(g * -1.4426950408889634f); return g * u * __builtin_amdgcn_rcpf(1.0f + e); }

struct EpiStore {
    static constexpr bool PERM = true, AFTER_DRAIN = false, RSTD = false;
    bf16_t* O; int ldc;
    __device__ __forceinline__ void operator()(const f32x4 (&acc)[2][2][4][2], const Unit& u, int wr, int wc, int fr, int fq) const {
        const int z = opaque0(); const int row0 = u.pm * BM + wr * 64 + fr + z, col0 = u.pn * BM + wc * 32 + 8 * fq + z;
#pragma unroll
        for (int ai = 0; ai < 2; ++ai)
#pragma unroll
            for (int m = 0; m < 4; ++m) { bf16_t* rowp = O + (size_t)(row0 + ai * HALF + m * 16) * ldc + col0;
#pragma unroll
                for (int bj = 0; bj < 2; ++bj) { const f32x4 v0 = acc[ai][bj][m][0], v1 = acc[ai][bj][m][1];
                    u32x4 w; w.x = cvt_pk_bf16(v0[0], v0[1]); w.y = cvt_pk_bf16(v0[2], v0[3]); w.z = cvt_pk_bf16(v1[0], v1[1]); w.w = cvt_pk_bf16(v1[2], v1[3]);
                    *(u32x4*)(rowp + bj * HALF) = w; } }
    }
};
template <bool HALFM> struct EpiSwiGLU {
    static constexpr bool PERM = true, AFTER_DRAIN = false, RSTD = true;
    bf16_t* H; const float* ssq;
    __device__ __forceinline__ void prime(PG8_LAS float* rc, const Unit& u, int tid) const {
        if (tid < (HALFM ? HALF : BM)) rc[tid] = row_rstd(ssq, u.pm * (HALFM ? HALF : BM) + tid);
        asm volatile("s_waitcnt lgkmcnt(0)" ::: "memory");
    }
    __device__ __forceinline__ void operator()(const f32x4 (&acc)[2][2][4][2], const Unit& u, int wr, int wc, int fr, int fq, const PG8_LAS float* rc, bool cached) const {
        const int z = opaque0(); const int row0 = u.pm * (HALFM ? HALF : BM) + wr * 64 + fr + z, col0 = u.pn * HALF + wc * 32 + 8 * fq + z;
        float rsv[8];
        if (cached) {
#pragma unroll
            for (int i = 0; i < (HALFM ? 4 : 8); ++i) rsv[i] = rc[(i >> 2) * HALF + wr * 64 + (i & 3) * 16 + fr + z];
        } else rows_rstd<false>(rsv, ssq, row0, fq);
#pragma unroll
        for (int ai = 0; ai < (HALFM ? 1 : 2); ++ai)
#pragma unroll
            for (int m = 0; m < 4; ++m) { const int row = row0 + ai * HALF + m * 16; const float rs = rsv[ai * 4 + m];
                const f32x4 g0 = acc[ai][0][m][0] * rs, g1 = acc[ai][0][m][1] * rs, u0 = acc[ai][1][m][0] * rs, u1 = acc[ai][1][m][1] * rs;
                u32x4 w; w.x = cvt_pk_bf16(silu_mul(g0[0], u0[0]), silu_mul(g0[1], u0[1])); w.y = cvt_pk_bf16(silu_mul(g0[2], u0[2]), silu_mul(g0[3], u0[3]));
                w.z = cvt_pk_bf16(silu_mul(g1[0], u1[0]), silu_mul(g1[1], u1[1])); w.w = cvt_pk_bf16(silu_mul(g1[2], u1[2]), silu_mul(g1[3], u1[3]));
                *(u32x4*)(H + (size_t)row * 5632 + col0) = w; }
    }
};
struct EpiResid {
    static constexpr bool PERM = true, AFTER_DRAIN = false, RSTD = false;
    bf16_t* xb; float* ssq; float* fout; float alpha; int wf;
    __device__ __forceinline__ void operator()(const f32x4 (&acc)[2][2][4][2], const Unit& u, int wr, int wc, int fr, int fq) const {
        const int z = opaque0(); const int row0 = u.pm * BM + wr * 64 + fr + z, col0 = u.pn * BM + wc * 32 + 8 * fq + z;
#pragma unroll
        for (int ai = 0; ai < 2; ++ai) {
            u32x4 rb[4][2];
#pragma unroll
            for (int m = 0; m < 4; ++m) { const size_t off = (size_t)(row0 + ai * HALF + m * 16) * 2048 + col0;
#pragma unroll
                for (int bj = 0; bj < 2; ++bj) rb[m][bj] = *(const u32x4*)(xb + off + bj * HALF); }
            __builtin_amdgcn_sched_barrier(0);
#pragma unroll
            for (int m = 0; m < 4; ++m) { const int row = row0 + ai * HALF + m * 16; const size_t off = (size_t)row * 2048 + col0; float sq = 0.f;
#pragma unroll
                for (int bj = 0; bj < 2; ++bj) { const u32x4 r = rb[m][bj];
                    const f32x4 b0 = (f32x4){__builtin_bit_cast(float, r.x << 16), __builtin_bit_cast(float, r.x & 0xffff0000u), __builtin_bit_cast(float, r.y << 16), __builtin_bit_cast(float, r.y & 0xffff0000u)};
                    const f32x4 b1 = (f32x4){__builtin_bit_cast(float, r.z << 16), __builtin_bit_cast(float, r.z & 0xffff0000u), __builtin_bit_cast(float, r.w << 16), __builtin_bit_cast(float, r.w & 0xffff0000u)};
                    const f32x4 o0 = b0 + acc[ai][bj][m][0] * alpha, o1 = b1 + acc[ai][bj][m][1] * alpha;
                    if (wf) { *(f32x4*)(fout + off + bj * HALF) = o0; *(f32x4*)(fout + off + bj * HALF + 4) = o1; }
                    sq += (o0[0] * o0[0] + o0[1] * o0[1]) + (o0[2] * o0[2] + o0[3] * o0[3]) + (o1[0] * o1[0] + o1[1] * o1[1]) + (o1[2] * o1[2] + o1[3] * o1[3]);
                    u32x4 w; w.x = cvt_pk_bf16(o0[0], o0[1]); w.y = cvt_pk_bf16(o0[2], o0[3]); w.z = cvt_pk_bf16(o1[0], o1[1]); w.w = cvt_pk_bf16(o1[2], o1[3]);
                    *(u32x4*)(xb + off + bj * HALF) = w; }
                sq = sum_fq(sq);
                if (fq == 0) ssq[(size_t)row * 32 + u.pn * 4 + wc] = sq; }
            __builtin_amdgcn_sched_barrier(0); }
    }
};
struct EpiWin {
    static constexpr bool PERM = true, AFTER_DRAIN = false, RSTD = true;
    const float* ssq; bf16_t* UT; bf16_t* Qb; bf16_t* Kb; bf16_t* Vb; const float* cosT; const float* sinT; const float* gq; const float* gk;
    __device__ __forceinline__ void prime(PG8_LAS float* rc, const Unit& u, int tid) const {
        if (tid < BM) { const int ai = tid >> 7, wr_ = (tid >> 6) & 1, m = (tid >> 4) & 3, fr_ = tid & 15; rc[tid] = row_rstd(ssq, 512 * (u.pm & 15) + 32 * (u.pm >> 4) + 64 * (4 * ai + m) + 16 * wr_ + fr_); }
        asm volatile("s_waitcnt lgkmcnt(0)" ::: "memory");
    }
    __device__ __forceinline__ void operator()(const f32x4 (&acc)[2][2][4][2], const Unit& u, int wr, int wc, int fr, int fq, const PG8_LAS float* rc, bool cached) const {
        const int z = opaque0(); fq += z; const int b1 = u.pm & 15; const int tok0 = 512 * b1 + 32 * (u.pm >> 4) + 16 * wr + fr + z; const int sec = u.pn >> 2;
        float rsv[8];
        if (cached) {
#pragma unroll
            for (int i = 0; i < 8; ++i) rsv[i] = rc[(i >> 2) * HALF + wr * 64 + (i & 3) * 16 + fr + z];
        } else rows_rstd<true>(rsv, ssq, tok0, fq);
        if (sec == 0) {
            const int s2 = tok0 & 63;
#pragma unroll
            for (int bj = 0; bj < 2; ++bj)
#pragma unroll
                for (int n = 0; n < 2; ++n)
#pragma unroll
                    for (int e = 0; e < 4; ++e) { const int col = (u.pn & 3) * BM + bj * HALF + wc * 32 + 8 * fq + 4 * n + e;
                        u32x4 w; w.x = cvt_pk_bf16(acc[0][bj][0][n][e] * rsv[0], acc[0][bj][1][n][e] * rsv[1]); w.y = cvt_pk_bf16(acc[0][bj][2][n][e] * rsv[2], acc[0][bj][3][n][e] * rsv[3]);
                        w.z = cvt_pk_bf16(acc[1][bj][0][n][e] * rsv[4], acc[1][bj][1][n][e] * rsv[5]); w.w = cvt_pk_bf16(acc[1][bj][2][n][e] * rsv[6], acc[1][bj][3][n][e] * rsv[7]);
                        *(u32x4*)(UT + ((size_t)(col * 64 + s2) * 128 + 8 * b1)) = w; }
        } else if (sec == 3) {
            const int col0 = (u.pn & 3) * BM + wc * 32 + 8 * fq;
#pragma unroll
            for (int ai = 0; ai < 2; ++ai)
#pragma unroll
                for (int m = 0; m < 4; ++m) { const int row = tok0 + 64 * (ai * 4 + m); const float rs = rsv[ai * 4 + m];
#pragma unroll
                    for (int bj = 0; bj < 2; ++bj) { const f32x4 v0 = acc[ai][bj][m][0] * rs, v1 = acc[ai][bj][m][1] * rs;
                        u32x4 w; w.x = cvt_pk_bf16(v0[0], v0[1]); w.y = cvt_pk_bf16(v0[2], v0[3]); w.z = cvt_pk_bf16(v1[0], v1[1]); w.w = cvt_pk_bf16(v1[2], v1[3]);
                        *(u32x4*)(Vb + (size_t)row * 1024 + col0 + bj * HALF) = w; } }
        } else {
            const bool isq = sec == 1; const float* gv = isq ? gq : gk; bf16_t* dst = isq ? Qb : Kb; const float osc = isq ? 0.125f * 1.4426950408889634f : 1.0f;
            const int vec = (u.pn & 3) * 4 + wc;
            const f32x4 ga0 = *(const f32x4*)(gv + 8 * fq), ga1 = *(const f32x4*)(gv + 8 * fq + 4), gb0 = *(const f32x4*)(gv + 32 + 8 * fq), gb1 = *(const f32x4*)(gv + 32 + 8 * fq + 4);
#pragma unroll
            for (int ah = 0; ah < 4; ++ah) { const int ai = ah >> 1, mh = (ah & 1) * 2;
                f32x4 cs[2][4];
#pragma unroll
                for (int mm = 0; mm < 2; ++mm) { const int m = mh + mm; const size_t ro = (size_t)(tok0 + 64 * (ai * 4 + m)) * 32 + 8 * fq;
                    cs[mm][0] = *(const f32x4*)(cosT + ro); cs[mm][1] = *(const f32x4*)(cosT + ro + 4); cs[mm][2] = *(const f32x4*)(sinT + ro); cs[mm][3] = *(const f32x4*)(sinT + ro + 4); }
                __builtin_amdgcn_sched_barrier(0);
#pragma unroll
                for (int mm = 0; mm < 2; ++mm) { const int m = mh + mm; const int row = tok0 + 64 * (ai * 4 + m); const float rs = rsv[ai * 4 + m];
                    f32x4 a0 = acc[ai][0][m][0] * rs, a1 = acc[ai][0][m][1] * rs, b0 = acc[ai][1][m][0] * rs, b1v = acc[ai][1][m][1] * rs;
                    float sq = (a0[0] * a0[0] + a0[1] * a0[1]) + (a0[2] * a0[2] + a0[3] * a0[3]) + (a1[0] * a1[0] + a1[1] * a1[1]) + (a1[2] * a1[2] + a1[3] * a1[3])
                             + (b0[0] * b0[0] + b0[1] * b0[1]) + (b0[2] * b0[2] + b0[3] * b0[3]) + (b1v[0] * b1v[0] + b1v[1] * b1v[1]) + (b1v[2] * b1v[2] + b1v[3] * b1v[3]);
                    sq = sum_fq(sq);
                    const float rn = 1.0f / sqrtf(sq * (1.0f / 64.0f) + 1e-6f);
                    a0 = a0 * rn * ga0; a1 = a1 * rn * ga1; b0 = b0 * rn * gb0; b1v = b1v * rn * gb1;
                    const f32x4 c0 = cs[mm][0], c1 = cs[mm][1], s0 = cs[mm][2], s1 = cs[mm][3];
                    const f32x4 lo0 = (a0 * c0 - b0 * s0) * osc, lo1 = (a1 * c1 - b1v * s1) * osc, hi0 = (b0 * c0 + a0 * s0) * osc, hi1 = (b1v * c1 + a1 * s1) * osc;
                    u32x4 w; w.x = cvt_pk_bf16(lo0[0], lo0[1]); w.y = cvt_pk_bf16(lo0[2], lo0[3]); w.z = cvt_pk_bf16(lo1[0], lo1[1]); w.w = cvt_pk_bf16(lo1[2], lo1[3]);
                    *(u32x4*)(dst + (size_t)row * 1024 + vec * 64 + 8 * fq) = w;
                    w.x = cvt_pk_bf16(hi0[0], hi0[1]); w.y = cvt_pk_bf16(hi0[2], hi0[3]); w.z = cvt_pk_bf16(hi1[0], hi1[1]); w.w = cvt_pk_bf16(hi1[2], hi1[3]);
                    *(u32x4*)(dst + (size_t)row * 1024 + vec * 64 + 32 + 8 * fq) = w; }
                __builtin_amdgcn_sched_barrier(0); }
        }
    }
};
struct EpiFft1 {
    static constexpr bool PERM = true, AFTER_DRAIN = false, RSTD = false;
    bf16_t* O1T; const float* TWC; const float* TWS;
    __device__ __forceinline__ void operator()(const f32x4 (&acc)[2][2][4][2], const Unit& u, int wr, int wc, int fr, int fq) const {
        const int z = opaque0(); fr += z; const int s2 = 32 * (wc & 1) + 8 * fq + z;
#pragma unroll
        for (int m = 0; m < 4; ++m) { const int k1 = wr * 64 + m * 16 + fr;
            const f32x4 c0 = *(const f32x4*)(TWC + k1 * 64 + s2), c1 = *(const f32x4*)(TWC + k1 * 64 + s2 + 4), s0 = *(const f32x4*)(TWS + k1 * 64 + s2), s1 = *(const f32x4*)(TWS + k1 * 64 + s2 + 4);
#pragma unroll
            for (int bj = 0; bj < 2; ++bj) { const int col = 4 * u.pn + 2 * bj + (wc >> 1);
                const f32x4 r0 = acc[0][bj][m][0], r1 = acc[0][bj][m][1], i0 = acc[1][bj][m][0], i1 = acc[1][bj][m][1];
                const f32x4 or0 = r0 * c0 + i0 * s0, or1 = r1 * c1 + i1 * s1, oi0 = i0 * c0 - r0 * s0, oi1 = i1 * c1 - r1 * s1;
                bf16_t* dst = O1T + ((size_t)k1 * 1024 + col) * 128 + s2;
                u32x4 w; w.x = cvt_pk_bf16(or0[0], or0[1]); w.y = cvt_pk_bf16(or0[2], or0[3]); w.z = cvt_pk_bf16(or1[0], or1[1]); w.w = cvt_pk_bf16(or1[2], or1[3]);
                *(u32x4*)dst = w;
                w.x = cvt_pk_bf16(oi0[0], oi0[1]); w.y = cvt_pk_bf16(oi0[2], oi0[3]); w.z = cvt_pk_bf16(oi1[0], oi1[1]); w.w = cvt_pk_bf16(oi1[2], oi1[3]);
                *(u32x4*)(dst + 64) = w; }
            asm volatile("" ::: "memory"); }
    }
};
struct EpiFft2 {
    static constexpr bool PERM = true, AFTER_DRAIN = true, RSTD = false;
    bf16_t* YA; const bf16_t* DT;
    static __device__ __forceinline__ unsigned pk_rne(float lo, float hi) { unsigned a = __builtin_bit_cast(unsigned, lo), b = __builtin_bit_cast(unsigned, hi);
        a = (a + 0x7fffu + ((a >> 16) & 1u)) >> 16; b = (b + 0x7fffu + ((b >> 16) & 1u)) & 0xffff0000u; return a | b; }
    static constexpr int XP = 528, XG = 64 * XP;
    __device__ __forceinline__ void fused(const f32x4 (&acc)[2][2][4][2], const Unit& u, int wr, int wc, int fr, int fq, PG8_LAS unsigned char* lds, int wid, int lane) const {
        typedef __attribute__((ext_vector_type(16))) float f32x16;
        const int k1 = u.pn >> 2;
#pragma unroll
        for (int m = 0; m < 4; ++m)
#pragma unroll
            for (int bj = 0; bj < 2; ++bj) { const f32x4 v0 = acc[0][bj][m][0], v1 = acc[0][bj][m][1];
                u32x4 w; w.x = cvt_pk_bf16(v0[0], v0[1]); w.y = cvt_pk_bf16(v0[2], v0[3]); w.z = cvt_pk_bf16(v1[0], v1[1]); w.w = cvt_pk_bf16(v1[2], v1[3]);
                *(PG8_LAS u32x4*)(lds + bj * XG + (m * 16 + fr) * XP + (wr * 128 + wc * 32 + 8 * fq) * 2) = w; }
        asm volatile("s_waitcnt lgkmcnt(0)\n\ts_barrier" ::: "memory");
        const int g2 = wid >> 2, cq = wid & 3, r32 = lane & 31, hi = lane >> 5;
        const bf16_t* dtp = DT + (32 * cq + r32) * 256 + 8 * hi;
        const PG8_LAS unsigned char* xp = lds + g2 * XG + r32 * XP + 16 * hi;
        f32x16 y0 = {}, y1 = {};
#pragma unroll
        for (int kh = 0; kh < 2; ++kh) { bf16x8 a[8];
#pragma unroll
            for (int ks = 0; ks < 8; ++ks) a[ks] = *(const bf16x8*)(dtp + 16 * (8 * kh + ks));
#pragma unroll
            for (int ks = 0; ks < 8; ++ks) { const bf16x8 b0 = *(const PG8_LAS bf16x8*)(xp + 32 * (8 * kh + ks)), b1 = *(const PG8_LAS bf16x8*)(xp + 32 * XP + 32 * (8 * kh + ks));
                y0 = __builtin_amdgcn_mfma_f32_32x32x16_bf16(a[ks], b0, y0, 0, 0, 0); y1 = __builtin_amdgcn_mfma_f32_32x32x16_bf16(a[ks], b1, y1, 0, 0, 0); } }
        bf16_t* yb = YA + (size_t)(k1 + 128 * r32) * 2048 + (2 * (u.pn & 3) + g2) * 128 + 32 * cq + 4 * hi;
#pragma unroll
        for (int q = 0; q < 4; ++q) {
            u32x2 w0; w0.x = pk_rne(y0[4 * q], y0[4 * q + 1]); w0.y = pk_rne(y0[4 * q + 2], y0[4 * q + 3]); *(u32x2*)(yb + 8 * q) = w0;
            u32x2 w1; w1.x = pk_rne(y1[4 * q], y1[4 * q + 1]); w1.y = pk_rne(y1[4 * q + 2], y1[4 * q + 3]); *(u32x2*)(yb + (size_t)(128 * 32) * 2048 + 8 * q) = w1; }
        asm volatile("s_waitcnt lgkmcnt(0)\n\ts_barrier" ::: "memory");
    }
};
template <class Epi, class Sched, bool ALIGN_EPI = false, bool SP2 = false, bool HALFM = false, bool AMAP = false>
__device__ __forceinline__ void gemm_phase(PG8_LAS unsigned char* lds, const Gemm g, const Sched& S, const Epi& E, int tid_in) {
    int tid_ = tid_in; const char* gA = (const char*)g.A; const char* gB = (const char*)g.Bt;
    asm volatile("" : "+v"(tid_), "+s"(gA), "+s"(gB));
    const int tid = tid_, wid = __builtin_amdgcn_readfirstlane(tid >> 6), lane = tid & 63, wr = wid >> 2, wc = wid & 3, fr = lane & 15, fq = lane >> 4;
    static_assert(!HALFM || SP2, "HALFM is implemented for the SP2 loop only");
    const int K = g.K, nt = K / BK;
    unsigned voffA[2], voffB[2];
#pragma unroll
    for (int i = 0; i < 2; ++i) { int R, C; stage_rc(tid * 16 + i * 8192, R, C); const int Rb = Epi::PERM ? ((R & ~31) + perm32(R & 31)) : R;
        const int Ra = AMAP ? (64 * ((R >> 4) & 3) + 16 * (R >> 6) + (R & 15)) : R;
        voffA[i] = (unsigned)(Ra * g.lda + C) * 2u; voffB[i] = (unsigned)(Rb * g.ldb + C) * 2u; }
    const size_t kstep = (size_t)(BK * 2);
    const size_t hstepA = (size_t)(AMAP ? 256 : HALF) * g.lda * 2, hstepB = (size_t)HALF * g.ldb * 2;
    const size_t tstepA = HALFM ? hstepA : 2 * hstepA, tstepB = 2 * hstepB;
    const unsigned ldsw = (unsigned)wid * 1024u;
    const int aoff = lds_byte(wr * 64 + fr, fq * 8), boff = lds_byte(wc * 32 + fr, fq * 8);
#define PG8_SA(b, h) (((b) * 2 + (h)) * HTB)
#define PG8_SB(b, h) ((4 + (b) * 2 + (h)) * HTB)
#define PG8_STAGE(bufoff, gbase, voff) do { _Pragma("unroll") for (int _i = 0; _i < 2; ++_i) \
        __builtin_amdgcn_global_load_lds((const unsigned*)((const char*)(gbase) + (voff)[_i]), (PG8_LAS unsigned*)(lds + (bufoff) + ldsw + _i * 8192), 16, 0, 0); } while (0)
#define PG8_LDA(dst, b, h) do { _Pragma("unroll") for (int m = 0; m < 4; ++m) _Pragma("unroll") for (int k = 0; k < 2; ++k) dst[m][k] = *(const PG8_LAS bf16x8*)(lds + PG8_SA(b, h) + aoff + m * 2048 + k * 1024); } while (0)
#define PG8_LDB(dst, b, h) do { _Pragma("unroll") for (int n = 0; n < 2; ++n) _Pragma("unroll") for (int k = 0; k < 2; ++k) dst[n][k] = *(const PG8_LAS bf16x8*)(lds + PG8_SB(b, h) + boff + n * 2048 + k * 1024); } while (0)
#define PG8_MMA(ai, bj, At, Bt) do { __builtin_amdgcn_s_setprio(1); _Pragma("unroll") for (int m = 0; m < 4; ++m) _Pragma("unroll") for (int n = 0; n < 2; ++n) _Pragma("unroll") for (int k = 0; k < 2; ++k) \
        acc[ai][bj][m][n] = __builtin_amdgcn_mfma_f32_16x16x32_bf16(Bt[n][k], At[m][k], acc[ai][bj][m][n], 0, 0, 0); __builtin_amdgcn_s_setprio(0); } while (0)
#define PG8_WAIT_V(n) asm volatile("s_waitcnt vmcnt(" #n ")" ::: "memory")
#define PG8_WAIT_L(n) asm volatile("s_waitcnt lgkmcnt(" #n ")" ::: "memory")
#define PG8_WAIT_VK do { if constexpr (HALFM) PG8_WAIT_V(6); else PG8_WAIT_V(8); } while (0)
#define PG8_BAR __builtin_amdgcn_s_barrier()
#define PG8_SCHED __builtin_amdgcn_sched_barrier(0)
    Unit cur, nxt; int ui = 0;
    if (!S.next(0, cur)) return;
    const int pm0 = cur.pm;
    f32x4 acc[2][2][4][2];
#pragma unroll
    for (int a = 0; a < 2; ++a)
#pragma unroll
        for (int b = 0; b < 2; ++b)
#pragma unroll
            for (int m = 0; m < 4; ++m)
#pragma unroll
                for (int n = 0; n < 2; ++n) acc[a][b][m][n] = (f32x4){0.f, 0.f, 0.f, 0.f};
    bf16x8 At[4][2], B0[2][2], B1[2][2];
#define PG8_ATILE(pm_) (AMAP ? (size_t)(512 * ((pm_) & 15) + 32 * ((pm_) >> 4)) * g.lda * 2 : (size_t)(pm_) * tstepA)
    const char* cA = gA + PG8_ATILE(cur.pm); const char* cB = gB + (size_t)cur.pn * tstepB;
    S.a_ready(cur);
    if constexpr (SP2) {
        PG8_STAGE(PG8_SB(0, 0), cB, voffB); PG8_STAGE(PG8_SB(0, 1), cB + hstepB, voffB); PG8_STAGE(PG8_SA(0, 0), cA, voffA); if constexpr (!HALFM) PG8_STAGE(PG8_SA(0, 1), cA + hstepA, voffA);
        if constexpr (Epi::RSTD) E.prime((PG8_LAS float*)(lds + STAGE_BYTES), cur, tid);
        if (wr == 1) PG8_BAR;
        if constexpr (HALFM) PG8_WAIT_V(0); else PG8_WAIT_V(2);
        PG8_BAR;
        PG8_STAGE(PG8_SB(1, 0), cB + kstep, voffB); PG8_STAGE(PG8_SA(1, 0), cA + kstep, voffA); PG8_STAGE(PG8_SB(1, 1), cB + hstepB + kstep, voffB);
        PG8_WAIT_V(6); PG8_BAR;
    } else {
        PG8_STAGE(PG8_SB(0, 0), cB, voffB); PG8_STAGE(PG8_SA(0, 0), cA, voffA); PG8_STAGE(PG8_SB(0, 1), cB + hstepB, voffB); PG8_STAGE(PG8_SA(0, 1), cA + hstepA, voffA);
        if constexpr (Epi::RSTD) E.prime((PG8_LAS float*)(lds + STAGE_BYTES), cur, tid);
        if (wr == 1) PG8_BAR;
        PG8_WAIT_V(4); PG8_BAR;
        PG8_STAGE(PG8_SB(1, 0), cB + kstep, voffB); PG8_STAGE(PG8_SA(1, 0), cA + kstep, voffA); PG8_STAGE(PG8_SB(1, 1), cB + hstepB + kstep, voffB);
        PG8_WAIT_V(6); PG8_BAR;
    }
    for (;;) {
        const bool has_next = S.next(ui + 1, nxt);
        const char* nA = has_next ? gA + PG8_ATILE(nxt.pm) : cA; const char* nB = has_next ? gB + (size_t)nxt.pn * tstepB : cB;
        for (int t = 0; t < nt; t += 2) {
            const bool last = (t == nt - 2);
            const char* a1 = cA + (size_t)(t + 1) * kstep;
            const char* a2 = last ? nA : cA + (size_t)(t + 2) * kstep; const char* b2 = last ? nB : cB + (size_t)(t + 2) * kstep;
            const char* a3 = a2 + kstep; const char* b3 = b2 + kstep;
            if (last && has_next) S.a_ready(nxt);
            if constexpr (SP2) {
            PG8_LDB(B0, 0, 0); PG8_LDB(B1, 0, 1); PG8_SCHED; PG8_LDA(At, 0, 0); if constexpr (!HALFM) PG8_STAGE(PG8_SA(1, 1), a1 + hstepA, voffA);
            PG8_WAIT_VK; PG8_WAIT_L(0); PG8_BAR; PG8_MMA(0, 0, At, B0); PG8_MMA(0, 1, At, B1); PG8_BAR; PG8_SCHED;
            if constexpr (!HALFM) { PG8_LDA(At, 0, 1); } PG8_STAGE(PG8_SB(0, 0), b2, voffB); PG8_STAGE(PG8_SB(0, 1), b2 + hstepB, voffB); PG8_STAGE(PG8_SA(0, 0), a2, voffA);
            PG8_WAIT_VK; PG8_WAIT_L(0); PG8_BAR; if constexpr (!HALFM) { PG8_MMA(1, 0, At, B0); PG8_MMA(1, 1, At, B1); } PG8_BAR; PG8_SCHED;
            PG8_LDB(B0, 1, 0); PG8_LDB(B1, 1, 1); PG8_SCHED; PG8_LDA(At, 1, 0); if constexpr (!HALFM) PG8_STAGE(PG8_SA(0, 1), a2 + hstepA, voffA);
            PG8_WAIT_VK; PG8_WAIT_L(0); PG8_BAR; PG8_MMA(0, 0, At, B0); PG8_MMA(0, 1, At, B1); PG8_BAR; PG8_SCHED;
            if constexpr (!HALFM) { PG8_LDA(At, 1, 1); } PG8_STAGE(PG8_SB(1, 0), b3, voffB); PG8_STAGE(PG8_SB(1, 1), b3 + hstepB, voffB); PG8_STAGE(PG8_SA(1, 0), a3, voffA);
            PG8_WAIT_VK; PG8_WAIT_L(0); PG8_BAR; if constexpr (!HALFM) { PG8_MMA(1, 0, At, B0); PG8_MMA(1, 1, At, B1); } PG8_BAR; PG8_SCHED;
            } else {
            PG8_LDB(B0, 0, 0); PG8_SCHED; PG8_LDA(At, 0, 0); PG8_STAGE(PG8_SA(1, 1), a1 + hstepA, voffA);
            PG8_WAIT_L(8); PG8_BAR; PG8_WAIT_L(0); PG8_MMA(0, 0, At, B0); PG8_BAR; PG8_SCHED;
            PG8_LDB(B1, 0, 1); PG8_STAGE(PG8_SB(0, 0), b2, voffB);
            PG8_BAR; PG8_WAIT_L(0); PG8_MMA(0, 1, At, B1); PG8_BAR;
            PG8_LDA(At, 0, 1); PG8_STAGE(PG8_SA(0, 0), a2, voffA);
            PG8_BAR; PG8_WAIT_L(0); PG8_MMA(1, 0, At, B0); PG8_BAR; PG8_SCHED;
            PG8_STAGE(PG8_SB(0, 1), b2 + hstepB, voffB);
            PG8_WAIT_V(6); PG8_BAR; PG8_MMA(1, 1, At, B1); PG8_BAR;
            PG8_LDB(B0, 1, 0); PG8_SCHED; PG8_LDA(At, 1, 0); PG8_STAGE(PG8_SA(0, 1), a2 + hstepA, voffA);
            PG8_WAIT_L(8); PG8_BAR; PG8_WAIT_L(0); PG8_MMA(0, 0, At, B0); PG8_BAR; PG8_SCHED;
            PG8_LDB(B1, 1, 1); PG8_STAGE(PG8_SB(1, 0), b3, voffB);
            PG8_BAR; PG8_WAIT_L(0); PG8_MMA(0, 1, At, B1); PG8_BAR;
            PG8_LDA(At, 1, 1); PG8_STAGE(PG8_SA(1, 0), a3, voffA);
            PG8_BAR; PG8_WAIT_L(0); PG8_MMA(1, 0, At, B0); PG8_BAR; PG8_SCHED;
            PG8_STAGE(PG8_SB(1, 1), b3 + hstepB, voffB);
            PG8_WAIT_V(6); PG8_BAR; PG8_MMA(1, 1, At, B1); PG8_BAR;
            }
        }
        if constexpr (ALIGN_EPI) { if (wr == 0) PG8_BAR; }
        if constexpr (!Epi::AFTER_DRAIN) { if constexpr (Epi::RSTD) E(acc, cur, wr, wc, fr, fq, (const PG8_LAS float*)(lds + STAGE_BYTES), cur.pm == pm0); else E(acc, cur, wr, wc, fr, fq); S.done(cur); }
        if (!has_next) break;
#pragma unroll
        for (int a = 0; a < 2; ++a)
#pragma unroll
            for (int b = 0; b < 2; ++b)
#pragma unroll
                for (int m = 0; m < 4; ++m)
#pragma unroll
                    for (int n = 0; n < 2; ++n) acc[a][b][m][n] = (f32x4){0.f, 0.f, 0.f, 0.f};
        cur = nxt; cA = nA; cB = nB; ++ui;
        if constexpr (ALIGN_EPI) { if (wr == 1) PG8_BAR; }
    }
    PG8_WAIT_V(0);
    if constexpr (!ALIGN_EPI) { if (wr == 0) PG8_BAR; }
    PG8_BAR;
    if constexpr (Epi::AFTER_DRAIN) { E.fused(acc, cur, wr, wc, fr, fq, lds, wid, lane); S.done(cur); }
#undef PG8_ATILE
#undef PG8_SA
#undef PG8_SB
#undef PG8_STAGE
#undef PG8_LDA
#undef PG8_LDB
#undef PG8_MMA
#undef PG8_WAIT_V
#undef PG8_WAIT_L
#undef PG8_WAIT_VK
#undef PG8_BAR
#undef PG8_SCHED
}
}

namespace att {
using bf16x8 = __attribute__((ext_vector_type(8))) short;
using s16x4  = __attribute__((ext_vector_type(4))) short;
using f32x4a = __attribute__((ext_vector_type(4))) float;
using u32x4  = __attribute__((ext_vector_type(4))) unsigned;
using f32x4v = __attribute__((ext_vector_type(4))) float;
#define LASP __attribute__((address_space(3)))
typedef unsigned short bf16_t;
constexpr int NW = 8, QBLK = 32, KVBLK = 64, SEQ = 8192, PITCH = 1024, NT = SEQ / KVBLK;
constexpr int SHM_V = KVBLK * 128 * 2, SHM_K = KVBLK * 64 * 2, NSTG = 6, STGB = SHM_K + SHM_V;
#define SBAR() __builtin_amdgcn_sched_barrier(0)
#define MM16(A_, B_, C_) __builtin_amdgcn_mfma_f32_16x16x32_bf16(A_, B_, C_, 0, 0, 0)
__device__ __forceinline__ unsigned cvtpk(float lo, float hi) { unsigned r; asm volatile("v_cvt_pk_bf16_f32 %0, %1, %2" : "=v"(r) : "v"(lo), "v"(hi)); return r; }
constexpr int v_rd_off(int db, int s, int hb) { return db * 2048 + s * 1024 + hb * 512; }
template <int OFF> __device__ __forceinline__ s16x4 tr_read(int vb) { s16x4 r; asm volatile("ds_read_b64_tr_b16 %0, %1 offset:%2" : "=&v"(r) : "v"(vb), "i"(OFF) : "memory"); return r; }
struct VSet { s16x4 l0, h0, l1, h1, l2, h2, l3, h3; };
template <int B> __device__ __forceinline__ void vread(VSet& v, int vb) {
  v.l0 = tr_read<v_rd_off(2 * B, 0, 0)>(vb); v.h0 = tr_read<v_rd_off(2 * B, 0, 1)>(vb); v.l1 = tr_read<v_rd_off(2 * B, 1, 0)>(vb); v.h1 = tr_read<v_rd_off(2 * B, 1, 1)>(vb);
  v.l2 = tr_read<v_rd_off(2 * B + 1, 0, 0)>(vb); v.h2 = tr_read<v_rd_off(2 * B + 1, 0, 1)>(vb); v.l3 = tr_read<v_rd_off(2 * B + 1, 1, 0)>(vb); v.h3 = tr_read<v_rd_off(2 * B + 1, 1, 1)>(vb);
}
template <int B> __device__ __forceinline__ void pvmm(f32x4a (&o)[2][8], const VSet& v, const bf16x8 (&pa)[2][2]) {
#define PK(L, H) (bf16x8){L[0], L[1], L[2], L[3], H[0], H[1], H[2], H[3]}
  const bf16x8 v00 = PK(v.l0, v.h0), v01 = PK(v.l1, v.h1), v10 = PK(v.l2, v.h2), v11 = PK(v.l3, v.h3);
  o[0][2 * B] = MM16(pa[0][0], v00, o[0][2 * B]); o[1][2 * B] = MM16(pa[1][0], v00, o[1][2 * B]); o[0][2 * B + 1] = MM16(pa[0][0], v10, o[0][2 * B + 1]); o[1][2 * B + 1] = MM16(pa[1][0], v10, o[1][2 * B + 1]);
  o[0][2 * B] = MM16(pa[0][1], v01, o[0][2 * B]); o[1][2 * B] = MM16(pa[1][1], v01, o[1][2 * B]); o[0][2 * B + 1] = MM16(pa[0][1], v11, o[0][2 * B + 1]); o[1][2 * B + 1] = MM16(pa[1][1], v11, o[1][2 * B + 1]);
#undef PK
}
__device__ __forceinline__ void kload(bf16x8 (&kf)[4][2], const char* Ks, int ko0, int ko1) {
#pragma unroll
  for (int kb = 0; kb < 4; ++kb) { kf[kb][0] = *reinterpret_cast<const bf16x8*>(Ks + ko0 + 2048 * kb); kf[kb][1] = *reinterpret_cast<const bf16x8*>(Ks + ko1 + 2048 * kb); }
}
__device__ __forceinline__ void qkt_r(f32x4a (&s)[4][2], const bf16x8 (&kf)[4][2], const bf16x8 (&qr)[2][2]) {
  const f32x4a z4 = {0.f, 0.f, 0.f, 0.f};
#pragma unroll
  for (int kb = 0; kb < 4; ++kb)
#pragma unroll
    for (int qb = 0; qb < 2; ++qb) s[kb][qb] = MM16(kf[kb][0], qr[qb][0], z4);
#pragma unroll
  for (int kb = 0; kb < 4; ++kb)
#pragma unroll
    for (int qb = 0; qb < 2; ++qb) s[kb][qb] = MM16(kf[kb][1], qr[qb][1], s[kb][qb]);
}
__device__ __forceinline__ void qkt2(f32x4a (&s)[4][2], const char* Ks, int ko0, int ko1, const bf16x8 (&qr)[2][2]) {
  const f32x4a z4 = {0.f, 0.f, 0.f, 0.f};
#pragma unroll
  for (int h2 = 0; h2 < 2; ++h2) { bf16x8 kf[2][2];
#pragma unroll
    for (int k2 = 0; k2 < 2; ++k2) { kf[k2][0] = *reinterpret_cast<const bf16x8*>(Ks + ko0 + 2048 * (2 * h2 + k2)); kf[k2][1] = *reinterpret_cast<const bf16x8*>(Ks + ko1 + 2048 * (2 * h2 + k2)); }
    SBAR();
#pragma unroll
    for (int k2 = 0; k2 < 2; ++k2)
#pragma unroll
      for (int qb = 0; qb < 2; ++qb) s[2 * h2 + k2][qb] = MM16(kf[k2][0], qr[qb][0], z4);
#pragma unroll
    for (int k2 = 0; k2 < 2; ++k2)
#pragma unroll
      for (int qb = 0; qb < 2; ++qb) s[2 * h2 + k2][qb] = MM16(kf[k2][1], qr[qb][1], s[2 * h2 + k2][qb]);
    SBAR(); }
}
#define LWAIT() do { asm volatile("s_waitcnt lgkmcnt(0)" ::: "memory"); SBAR(); } while (0)
__device__ __forceinline__ void finishSM(f32x4a (&s)[4][2], float& l0, float& l1, bf16x8 (&pa)[2][2]) {
#pragma unroll
  for (int kb = 0; kb < 4; ++kb)
#pragma unroll
    for (int qb = 0; qb < 2; ++qb)
#pragma unroll
      for (int e = 0; e < 4; ++e) s[kb][qb][e] = __builtin_amdgcn_exp2f(s[kb][qb][e]);
  float a0 = 0.f, a1 = 0.f, a2 = 0.f, a3 = 0.f, b0 = 0.f, b1 = 0.f, b2 = 0.f, b3 = 0.f;
#pragma unroll
  for (int kb = 0; kb < 4; ++kb) { a0 += s[kb][0][0]; a1 += s[kb][0][1]; a2 += s[kb][0][2]; a3 += s[kb][0][3]; b0 += s[kb][1][0]; b1 += s[kb][1][1]; b2 += s[kb][1][2]; b3 += s[kb][1][3]; }
  l0 += (a0 + a1) + (a2 + a3); l1 += (b0 + b1) + (b2 + b3);
#pragma unroll
  for (int qb = 0; qb < 2; ++qb)
#pragma unroll
    for (int st = 0; st < 2; ++st) { u32x4 w = {cvtpk(s[2 * st][qb][0], s[2 * st][qb][1]), cvtpk(s[2 * st][qb][2], s[2 * st][qb][3]), cvtpk(s[2 * st + 1][qb][0], s[2 * st + 1][qb][1]), cvtpk(s[2 * st + 1][qb][2], s[2 * st + 1][qb][3])};
      pa[qb][st] = *reinterpret_cast<bf16x8*>(&w); }
}

struct Tensors { const bf16_t* Q; const bf16_t* K; const bf16_t* V; bf16_t* YA; float* O0; const float* gsub; int lam_bits; int li_bits; };
constexpr int STG_LD = 132, STG_BYTES = 32 * STG_LD * 4;
constexpr int LDS_WS = NSTG * STGB > NW * STG_BYTES ? NSTG * STGB : NW * STG_BYTES, LDS_BYTES = LDS_WS + NW * 64 * 4;
__device__ __forceinline__ void attn_unit(int h, int qb_, const Tensors& T, char* lds, LASP unsigned char* ldsl, int tid_in) {
  int tid_ = tid_in; asm volatile("" : "+v"(tid_));
  const int tid = tid_, lane = tid & 63, c16 = lane & 15, g = lane >> 4; const int wid = __builtin_amdgcn_readfirstlane(tid >> 6);
  float* wsf = (float*)(lds + LDS_WS) + wid * 64; float* stg = (float*)(lds + wid * STG_BYTES);
  const int q0 = qb_ * (QBLK * NW);
  unsigned dK, dV0, dV1;
  { const int key = 8 * wid + (lane >> 3), ch = (lane & 7) ^ ((key >> 1) & 7); dK = (unsigned)((key * PITCH + ch * 8) * 2);
    { const int u = 64 * (2 * wid) + lane; dV0 = (unsigned)((((u >> 1) & 63) * PITCH + 16 * (u >> 7) + 8 * (u & 1)) * 2); }
    { const int u = 64 * (2 * wid + 1) + lane; dV1 = (unsigned)((((u >> 1) & 63) * PITCH + 16 * (u >> 7) + 8 * (u & 1)) * 2); } }
  const int vb0 = (int)(uintptr_t)lds + SHM_K + 128 * g + 32 * (c16 >> 2) + 8 * (c16 & 3);
  const int kx = (c16 >> 1) & 7, ko0 = c16 * 128 + ((g ^ kx) << 4), ko1 = c16 * 128 + (((4 + g) ^ kx) << 4);
  const size_t TILE_B = (size_t)KVBLK * PITCH * 2;
  unsigned op[2][8][2];
#pragma unroll
  for (int qb = 0; qb < 2; ++qb)
#pragma unroll
    for (int db = 0; db < 8; ++db) { op[qb][db][0] = 0u; op[qb][db][1] = 0u; }
  {
    const char* Kt = (const char*)(T.K + h * 128); const char* Vt = (const char*)(T.V + h * 128);
    const char* Qw = (const char*)T.Q + (size_t)(unsigned)(((q0 + wid * QBLK + c16) * PITCH + h * 128 + g * 8) * 2);
    bf16x8 qr[2][2];
#pragma unroll
    for (int qb = 0; qb < 2; ++qb)
#pragma unroll
      for (int ks = 0; ks < 2; ++ks) qr[qb][ks] = *reinterpret_cast<const bf16x8*>(Qw + qb * (16 * PITCH * 2) + ks * 64);
    float l0 = 0.f, l1 = 0.f; f32x4a o[2][8];
#pragma unroll
    for (int qb = 0; qb < 2; ++qb)
#pragma unroll
      for (int db = 0; db < 8; ++db) o[qb][db] = (f32x4a){0.f, 0.f, 0.f, 0.f};
#define ABAR() asm volatile("s_waitcnt lgkmcnt(0)\n\ts_barrier" ::: "memory")
#define DMA_TILE(tt, sg_) do { const int tc_ = (tt) < 2 * NT ? (tt) : 2 * NT - 1; const char* kb_ = Kt + (size_t)(tc_ & (NT - 1)) * TILE_B + (tc_ >> 7) * 128; const char* vb_ = Vt + (size_t)(tc_ & (NT - 1)) * TILE_B; asm volatile("" : "+s"(kb_), "+s"(vb_)); \
      LASP unsigned char* sb_ = ldsl + (sg_) * STGB; \
      __builtin_amdgcn_global_load_lds((const unsigned*)(kb_ + dK), (LASP unsigned*)(sb_ + wid * 1024), 16, 0, 0); \
      __builtin_amdgcn_global_load_lds((const unsigned*)(vb_ + dV0), (LASP unsigned*)(sb_ + SHM_K + (2 * wid) * 1024), 16, 0, 0); \
      __builtin_amdgcn_global_load_lds((const unsigned*)(vb_ + dV1), (LASP unsigned*)(sb_ + SHM_K + (2 * wid + 1) * 1024), 16, 0, 0); } while (0)
    const int hf = wid >> 2; constexpr int dist = 4;
    f32x4a s[4][2]; bf16x8 pa[2][2];
    DMA_TILE(0, 0); DMA_TILE(1, 1); DMA_TILE(2, 2); DMA_TILE(3, 3);
    asm volatile("s_waitcnt vmcnt(6)" ::: "memory");
    __syncthreads();
    VSet va, vb_;
    if (hf) { __builtin_amdgcn_s_setprio(1); ABAR(); }
    qkt2(s, lds, ko0, ko1, qr);
    if (!hf) ABAR();
    int sgv = 0, sgd = dist;
#pragma unroll 1
    for (int t = 0; t < 2 * NT; ++t) {
      DMA_TILE(t + dist, sgd); sgd = sgd == NSTG - 1 ? 0 : sgd + 1;
      if (t == NT - 1) {
#pragma unroll
        for (int qb = 0; qb < 2; ++qb)
#pragma unroll
          for (int ks = 0; ks < 2; ++ks) qr[qb][ks] = *reinterpret_cast<const bf16x8*>(Qw + 128 + qb * (16 * PITCH * 2) + ks * 64); }
      SBAR();
      finishSM(s, l0, l1, pa);
      if (hf) { asm volatile("s_waitcnt vmcnt(6)" ::: "memory"); ABAR(); }
      { const int vbt = vb0 + sgv * STGB; const int sgk = sgv == NSTG - 1 ? 0 : sgv + 1;
        vread<0>(va, vbt); SBAR();
        if (t + 1 < 2 * NT) qkt2(s, lds + sgk * STGB, ko0, ko1, qr);
        LWAIT(); vread<1>(vb_, vbt); SBAR(); pvmm<0>(o, va, pa); SBAR();
        LWAIT(); vread<2>(va, vbt); SBAR(); pvmm<1>(o, vb_, pa); SBAR();
        LWAIT(); vread<3>(vb_, vbt); SBAR(); pvmm<2>(o, va, pa); SBAR();
        LWAIT(); pvmm<3>(o, vb_, pa); SBAR();
        sgv = sgk; }
      if (t == NT - 1) {
        l0 = pg8::sum_fq(l0); l1 = pg8::sum_fq(l1);
        int ln; asm volatile("v_mbcnt_lo_u32_b32 %0, -1, 0\n\tv_mbcnt_hi_u32_b32 %0, -1, %0" : "=v"(ln));
        if ((ln >> 4) == 0) { wsf[ln & 15] = l0; wsf[16 + (ln & 15)] = l1; }
        asm volatile("s_waitcnt lgkmcnt(0)" ::: "memory");
#pragma unroll
        for (int qb = 0; qb < 2; ++qb) { const f32x4v lv = *(const f32x4v*)(wsf + 16 * qb + 4 * (ln >> 4));
          const float r0 = __builtin_amdgcn_rcpf(lv[0]), r1 = __builtin_amdgcn_rcpf(lv[1]), r2 = __builtin_amdgcn_rcpf(lv[2]), r3 = __builtin_amdgcn_rcpf(lv[3]);
#pragma unroll
          for (int db = 0; db < 8; ++db) { op[qb][db][0] = cvtpk(o[qb][db][0] * r0, o[qb][db][1] * r1); op[qb][db][1] = cvtpk(o[qb][db][2] * r2, o[qb][db][3] * r3); o[qb][db] = (f32x4a){0.f, 0.f, 0.f, 0.f}; } }
        asm volatile("s_waitcnt lgkmcnt(0)" ::: "memory");
        l0 = 0.f; l1 = 0.f; }
      if (!hf) { asm volatile("s_waitcnt vmcnt(6)" ::: "memory"); ABAR(); }
    }
    __builtin_amdgcn_s_setprio(0);
    asm volatile("s_waitcnt vmcnt(0)" ::: "memory");
#undef ABAR
#undef DMA_TILE
    l0 = pg8::sum_fq(l0); l1 = pg8::sum_fq(l1);
    int lane2; asm volatile("v_mbcnt_lo_u32_b32 %0, -1, 0\n\tv_mbcnt_hi_u32_b32 %0, -1, %0" : "=v"(lane2));
    const int c16e = lane2 & 15, ge = lane2 >> 4;
    if (ge == 0) { wsf[c16e] = l0; wsf[16 + c16e] = l1; }
    asm volatile("s_waitcnt lgkmcnt(0)" ::: "memory");
    {
      __syncthreads();
      int lb_ = T.lam_bits, ib_ = T.li_bits; asm volatile("" : "+s"(lb_), "+s"(ib_));
      const float lam = __builtin_bit_cast(float, lb_), osc = 1.0f - __builtin_bit_cast(float, ib_);
      const int lr = lane2 >> 3, ch = lane2 & 7;
      f32x4v gs[4];
#pragma unroll
      for (int i = 0; i < 4; ++i) gs[i] = *(const f32x4v*)(T.gsub + 16 * ch + 4 * i);
      { float* sw = stg + (4 * ge) * STG_LD + c16e;
#pragma unroll
        for (int qb = 0; qb < 2; ++qb) { const f32x4v lv = *(const f32x4v*)(wsf + 16 * qb + 4 * ge);
#pragma unroll
          for (int e = 0; e < 4; ++e) { const float rl = __builtin_amdgcn_rcpf(lv[e]) * lam;
#pragma unroll
            for (int db = 0; db < 8; ++db) { const unsigned w = op[qb][db][e >> 1]; const float o0 = __builtin_bit_cast(float, (e & 1) ? (w & 0xffff0000u) : (w << 16));
              sw[(16 * qb + e) * STG_LD + 16 * db] = o0 - o[qb][db][e] * rl; } } } }
      asm volatile("s_waitcnt lgkmcnt(0)" ::: "memory");
#pragma unroll
      for (int i = 0; i < 4; ++i) gs[i] = gs[i] * osc;
#pragma unroll 1
      for (int j = 0; j < 4; ++j) { const int row = 8 * j + lr; const float* sp = stg + row * STG_LD + 16 * ch;
        f32x4v a[4]; float ss = 0.f;
#pragma unroll
        for (int i = 0; i < 4; ++i) { a[i] = *(const f32x4v*)(sp + 4 * i); ss += (a[i][0] * a[i][0] + a[i][1] * a[i][1]) + (a[i][2] * a[i][2] + a[i][3] * a[i][3]); }
        ss = pg8::sum8(ss);
        const float rn = 1.0f / sqrtf(ss * (1.0f / 128.0f) + 1e-5f);
        u32x4 w0, w1;
        { const f32x4v y0 = a[0] * rn * gs[0], y1 = a[1] * rn * gs[1], y2 = a[2] * rn * gs[2], y3 = a[3] * rn * gs[3];
          w0 = (u32x4){cvtpk(y0[0], y0[1]), cvtpk(y0[2], y0[3]), cvtpk(y1[0], y1[1]), cvtpk(y1[2], y1[3])}; w1 = (u32x4){cvtpk(y2[0], y2[1]), cvtpk(y2[2], y2[3]), cvtpk(y3[0], y3[1]), cvtpk(y3[2], y3[3])}; }
        char* yp = (char*)T.YA + (size_t)(unsigned)(((q0 + wid * QBLK + row) * 2048 + 1024 + h * 128 + 16 * ch) * 2);
        *(u32x4*)yp = w0; *(u32x4*)(yp + 16) = w1; }
      asm volatile("s_waitcnt vmcnt(0) lgkmcnt(0)" ::: "memory");
      __syncthreads();
    }
  }
}

#undef LWAIT
#undef SBAR
}

constexpr int NWAVES = 8;
constexpr int GEMM_WGM = 4;
constexpr int SEQ = 8192, DM = 2048, DFF = 5632, DEPTH = 4, INW = 4096;
constexpr size_t MiB = 1u << 20;
constexpr size_t WS_CTL = 0, CTL_ZERO_BYTES = 1 * MiB;
constexpr size_t WS_COS = 1 * MiB, WS_SIN = 2 * MiB, WS_SSQ = 3 * MiB;
constexpr size_t WS_A1 = 4 * MiB, WS_A2 = WS_A1 + 65536, WS_TWC = WS_A2 + 65536, WS_TWS = WS_TWC + 32768, WS_LAM = WS_TWS + 32768;
constexpr size_t WS_DT = 5 * MiB;
constexpr size_t WS_XB = 16 * MiB;
constexpr size_t WS_H = 48 * MiB;
constexpr size_t WS_UF = 136 * MiB, WS_UT = 152 * MiB;
constexpr size_t WS_O1T = 168 * MiB;
constexpr size_t WS_YA = 200 * MiB;
constexpr size_t WS_Q = 248 * MiB, WS_K = 264 * MiB, WS_V = 280 * MiB;
constexpr size_t WS_O0 = 296 * MiB;
constexpr size_t WS_WGU = 328 * MiB, SZ_WGU = 44 * MiB;
constexpr size_t WS_WDN = 680 * MiB, SZ_WDN = 22 * MiB;
constexpr size_t WS_WIN = 856 * MiB, SZ_WIN = 16 * MiB;
constexpr size_t WS_WOUT = 920 * MiB, SZ_WOUT = 8 * MiB;
constexpr size_t WS_END = 952 * MiB;
constexpr int CW_BAR = 4096;
constexpr int RING_OFF = 0, RING_BYTES = 151552, LDSCTL_OFF = RING_BYTES, MISC_OFF = LDSCTL_OFF + 320, LDS_BYTES = 155648;
static_assert(att::LDS_BYTES <= RING_BYTES && pg8::STAGE_BYTES <= RING_BYTES && MISC_OFF + 128 <= LDS_BYTES, "LDS map");

#define GAS __attribute__((address_space(1)))
#define LAS __attribute__((address_space(3)))
typedef unsigned short bf16;
typedef unsigned v4u __attribute__((ext_vector_type(4)));
typedef float f32x4 __attribute__((ext_vector_type(4)));
#define LDS_WAIT() asm volatile("s_waitcnt lgkmcnt(0)" ::: "memory")
__device__ __forceinline__ unsigned f2bf(float f) { unsigned u = __builtin_bit_cast(unsigned, f); return (u + 0x7fffu + ((u >> 16) & 1u)) >> 16; }
__device__ __forceinline__ unsigned pk2(float lo, float hi) { return f2bf(lo) | (f2bf(hi) << 16); }

#define XB_TMO      128
#define XB_XCNT(j)  (256  + 64 * (j))
#define XB_XSUB(j)  (1280 + 64 * (j))
#define XB_XGEN(j)  (2304 + 64 * (j))
#define XB_TOP      3328
#define XB_TOPGEN   3392
#define XCD_BAR_WORDS 3456
#define XB_SPIN_CAP (1u << 18)

__device__ __forceinline__ unsigned xb_ld(unsigned* p)              { return __hip_atomic_load(p, __ATOMIC_RELAXED, __HIP_MEMORY_SCOPE_AGENT); }
__device__ __forceinline__ unsigned xb_add(unsigned* p, unsigned v) { return __hip_atomic_fetch_add(p, v, __ATOMIC_RELAXED, __HIP_MEMORY_SCOPE_AGENT); }
__device__ __forceinline__ unsigned xb_xcc_id() { return (unsigned)__builtin_amdgcn_s_getreg((3 << 11) | 20) & 0xFu; }
#define XB_SPIN(cond, bar) do { unsigned _sp = 0; while (cond) { __builtin_amdgcn_s_sleep(1); \
    if ((++_sp & 255u) == 0u) { if (xb_ld(&(bar)[XB_TMO])) break; if (_sp > XB_SPIN_CAP) { atomicAdd(&(bar)[XB_TMO], 1u); break; } } } } while (0)

struct XcdBarrier {
    unsigned* bar; unsigned x;
    volatile LAS unsigned* st;
};

__device__ __forceinline__ XcdBarrier xcd_barrier_post(unsigned* bar, volatile LAS unsigned* st, bool leader) {
    XcdBarrier b; b.bar = bar; b.x = xb_xcc_id(); b.st = st;
    if (leader) (void)xb_add(&bar[XB_XCNT(b.x)], 1u);
    return b;
}
__device__ __forceinline__ void xcd_barrier_complete(unsigned* bar, unsigned x, unsigned& nloc, unsigned& nx) {
    const unsigned G = gridDim.x * gridDim.y * gridDim.z;
    unsigned sum, cnt, mine, sp = 0u;
    for (;;) {
        sum = 0u; cnt = 0u; mine = 0u;
#pragma unroll
        for (unsigned j = 0; j < 16; ++j) { const unsigned c = xb_ld(&bar[XB_XCNT(j)]); sum += c; cnt += (c > 0u) ? 1u : 0u; mine = (j == x) ? c : mine; }
        if (sum == G) break;
        __builtin_amdgcn_s_sleep(1);
        if ((++sp & 255u) == 0u) { if (xb_ld(&bar[XB_TMO])) break; if (sp > XB_SPIN_CAP) { atomicAdd(&bar[XB_TMO], 1u); break; } }
    }
    nloc = mine > 0u ? mine : 1u; nx = cnt > 0u ? cnt : 1u;
}

__device__ __forceinline__ void xcd_barrier(const XcdBarrier& b, bool leader) {
    asm volatile("s_waitcnt vmcnt(0)" ::: "memory");
    __syncthreads();
    if (leader) {
        unsigned* bar = b.bar;
        __builtin_amdgcn_s_waitcnt(0);
        unsigned nloc = b.st[0], nx = b.st[1];
        if (nloc == 0u) { xcd_barrier_complete(bar, b.x, nloc, nx); b.st[0] = nloc; b.st[1] = nx; }
        const unsigned old = xb_add(&bar[XB_XSUB(b.x)], 1u);
        const unsigned gen = old / nloc;
        if (old + 1u == (gen + 1u) * nloc) {
            __builtin_amdgcn_fence(__ATOMIC_RELEASE, "agent");
            asm volatile("s_waitcnt vmcnt(0)" ::: "memory");
            const unsigned og = xb_add(&bar[XB_TOP], 1u);
            const unsigned tg = og / nx;
            if (og + 1u == (tg + 1u) * nx) xb_add(&bar[XB_TOPGEN], 1u);
            else XB_SPIN(xb_ld(&bar[XB_TOPGEN]) == tg, bar);
            __builtin_amdgcn_fence(__ATOMIC_ACQUIRE, "agent");
            xb_add(&bar[XB_XGEN(b.x)], 1u);
            asm volatile("s_waitcnt vmcnt(0)" ::: "memory");
        } else {
            XB_SPIN(xb_ld(&bar[XB_XGEN(b.x)]) == gen, bar);
            __builtin_amdgcn_fence(__ATOMIC_ACQUIRE, "agent");
            asm volatile("s_waitcnt vmcnt(0)" ::: "memory");
        }
    }
    __syncthreads();
}

__device__ __forceinline__ float wave_sum(float v) {
    v = pg8::sum8(v); v += pg8::dpp_f<0x140>(v);
    return pg8::sum_xor32(pg8::sum_xor16(v));
}
struct Args { const float* in[20]; float* out; unsigned char* ws; float lam_init[4]; };
typedef const Args __attribute__((address_space(4))) * KArgP;
struct Item { const float* src; const float* gain; bf16* dst; int ldsrc, scol0, k0, ldd, drow, dk0; };
__device__ __forceinline__ void tr_load(const Item& I, f32x4 (&v)[8], int lane) {
    const int lr = lane >> 3, lc = lane & 7;
#pragma unroll
    for (int i = 0; i < 8; ++i) v[i] = __builtin_nontemporal_load((const GAS f32x4*)(I.src + (size_t)(I.k0 + i * 8 + lr) * I.ldsrc + I.scol0 + 4 * lc));
}
__device__ __forceinline__ void tr_finish(const Item& I, const f32x4 (&v)[8], LAS float* scr, int lane) {
    const int lr = lane >> 3, lc = lane & 7;
    f32x4 g0 = (f32x4){1.f, 1.f, 1.f, 1.f}, g1 = g0;
    if (I.gain) { g0 = *(const GAS f32x4*)(I.gain + I.k0 + 8 * lc); g1 = *(const GAS f32x4*)(I.gain + I.k0 + 8 * lc + 4); }
#pragma unroll
    for (int i = 0; i < 8; ++i) { LAS float* s = scr + (i * 8 + lr) * 33 + 4 * lc; s[0] = v[i][0]; s[1] = v[i][1]; s[2] = v[i][2]; s[3] = v[i][3]; }
    LDS_WAIT(); asm volatile("" ::: "memory");
#pragma unroll
    for (int j = 0; j < 4; ++j) { const int n = lr + 8 * j; const LAS float* s = scr + (8 * lc) * 33 + n;
        v4u o; o.x = pg8::cvt_pk_bf16(s[0 * 33] * g0[0], s[1 * 33] * g0[1]); o.y = pg8::cvt_pk_bf16(s[2 * 33] * g0[2], s[3 * 33] * g0[3]); o.z = pg8::cvt_pk_bf16(s[4 * 33] * g1[0], s[5 * 33] * g1[1]); o.w = pg8::cvt_pk_bf16(s[6 * 33] * g1[2], s[7 * 33] * g1[3]);
        *(GAS v4u*)(I.dst + (size_t)(I.drow + n) * I.ldd + I.dk0 + 8 * lc) = o; }
    LDS_WAIT(); asm volatile("" ::: "memory");
}
constexpr int I_GU = 32 * 352, I_DN = 88 * 64, I_WIN = 32 * 128, I_WO = 32 * 64, I_L = 2 * I_GU + 2 * I_DN + I_WIN + I_WO;
__device__ __forceinline__ Item decode_item(KArgP argp, unsigned char* ws, int l, int it) {
    Item I; int r = it;
    if (r < 2 * I_GU) { const int f = r >= I_GU; r -= f * I_GU; const int kb = r / 352, nb = r - kb * 352, n0 = 32 * nb, t = n0 >> 8, s = (n0 >> 7) & 1, j0 = n0 & 127;
        I.src = argp->in[f ? (s ? 18 : 17) : (s ? 4 : 3)] + (size_t)l * DM * DFF; I.ldsrc = DFF; I.scol0 = 128 * t + j0; I.k0 = 64 * kb; I.gain = argp->in[f ? 16 : 2] + l * DM;
        I.dst = (bf16*)(ws + WS_WGU + (size_t)(l * 2 + f) * SZ_WGU); I.ldd = DM; I.drow = n0; I.dk0 = 64 * kb; return I; }
    r -= 2 * I_GU;
    if (r < 2 * I_DN) { const int f = r >= I_DN; r -= f * I_DN; const int kb = r >> 6, nb = r & 63;
        I.src = argp->in[f ? 19 : 5] + (size_t)l * DFF * DM; I.ldsrc = DM; I.scol0 = 32 * nb; I.k0 = 64 * kb; I.gain = nullptr;
        I.dst = (bf16*)(ws + WS_WDN + (size_t)(l * 2 + f) * SZ_WDN); I.ldd = DFF; I.drow = 32 * nb; I.dk0 = 64 * kb; return I; }
    r -= 2 * I_DN;
    if (r < I_WIN) { const int kb = r >> 7, nb = r & 127, n0 = 32 * nb, pn = n0 >> 8; int scol0 = n0;
        if (pn >= 4 && pn < 12) { const int tcol = n0 & 255, bj = tcol >> 7, wc = (tcol >> 5) & 3, vec = 4 * (pn & 3) + wc; scol0 = (pn < 8 ? 1024 : 2048) + vec * 64 + 32 * bj; }
        I.src = argp->in[7] + (size_t)l * DM * INW; I.ldsrc = INW; I.scol0 = scol0; I.k0 = 64 * kb; I.gain = argp->in[6] + l * DM;
        I.dst = (bf16*)(ws + WS_WIN + (size_t)l * SZ_WIN); I.ldd = DM; I.drow = n0; I.dk0 = 64 * kb; return I; }
    r -= I_WIN;
    { const int kb = r >> 6, nb = r & 63; I.src = argp->in[15] + (size_t)l * DM * DM; I.ldsrc = DM; I.scol0 = 32 * nb; I.k0 = 64 * kb; I.gain = nullptr; I.drow = 32 * nb;
      I.dst = (bf16*)(ws + WS_WOUT + (size_t)l * SZ_WOUT); I.ldd = DM; I.dk0 = 64 * kb; }
    return I;
}
__device__ __forceinline__ Item decode_global(KArgP argp, unsigned char* ws, int g) { const int q = g / I_L; return decode_item(argp, ws, DEPTH - 1 - q, g - q * I_L); }
__device__ __forceinline__ void p0_prologue(KArgP argp, LAS unsigned char* lds, int vcu, int G, int wave, int lane) {
    unsigned char* ws = argp->ws;
    LAS float* scr = (LAS float*)(lds + RING_OFF + wave * 16384);
    const int gw = vcu * NWAVES + wave, NGW = G * NWAVES;
    { int it = gw;
      if (it < DEPTH * I_L) { Item a = decode_global(argp, ws, it), b = a; f32x4 va[8], vb[8];
        tr_load(a, va, lane);
        for (;;) {
            it += NGW; const bool m1 = it < DEPTH * I_L; if (m1) { b = decode_global(argp, ws, it); tr_load(b, vb, lane); }
            tr_finish(a, va, scr, lane); if (!m1) break;
            it += NGW; const bool m2 = it < DEPTH * I_L; if (m2) { a = decode_global(argp, ws, it); tr_load(a, va, lane); }
            tr_finish(b, vb, scr, lane); if (!m2) break;
        } } }
    { const float* x = argp->in[0]; bf16* xb = (bf16*)(ws + WS_XB); float* ssq = (float*)(ws + WS_SSQ);
      for (int m = gw; m < SEQ; m += NGW) { const GAS f32x4* xr = (const GAS f32x4*)(x + (size_t)m * DM) + lane; f32x4 v[8]; float s = 0.f;
#pragma unroll
          for (int j = 0; j < 8; ++j) { v[j] = xr[64 * j]; s += (v[j][0] * v[j][0] + v[j][1] * v[j][1]) + (v[j][2] * v[j][2] + v[j][3] * v[j][3]); }
          s = wave_sum(s);
          GAS unsigned long long* o8 = (GAS unsigned long long*)(xb + (size_t)m * DM) + lane;
#pragma unroll
          for (int j = 0; j < 8; ++j) o8[64 * j] = (unsigned long long)pk2(v[j][0], v[j][1]) | ((unsigned long long)pk2(v[j][2], v[j][3]) << 32);
          if (lane < 32) ssq[(size_t)m * 32 + lane] = lane == 0 ? s : 0.f; } }
    const int gt = gw * 64 + lane, NGT = NGW * 64;
    { const int* pos = (const int*)argp->in[1]; float* cosT = (float*)(ws + WS_COS); float* sinT = (float*)(ws + WS_SIN);
      for (int e = gt; e < SEQ * 32; e += NGT) { const int t = e >> 5, i = e & 31; double f = 1.0; for (int k = 0; k < i; ++k) f *= 0.7498942093324559;
          double rev = (double)pos[t] * f * 0.15915494309189535; rev -= __builtin_floor(rev); const float fr = (float)rev;
          cosT[e] = __builtin_amdgcn_cosf(fr); sinT[e] = __builtin_amdgcn_sinf(fr); } }
    { bf16* A1 = (bf16*)(ws + WS_A1); bf16* A2 = (bf16*)(ws + WS_A2);
      for (int e = gt; e < 256 * 128; e += NGT) { const int r = e >> 7, cc = e & 127;
          { const int p = r >> 7, k1 = r & 127; const float ph = (float)((k1 * cc) & 127) * (1.0f / 128.0f);
            A1[e] = (bf16)f2bf((p == 0 ? __builtin_amdgcn_cosf(ph) : -__builtin_amdgcn_sinf(ph)) * 0.0625f); }
          { float val = 0.f; if (r < 128) { const int pp = r >> 6, k2 = r & 63, p = cc >> 6, s2 = cc & 63; const float ph = (float)((k2 * s2) & 63) * (1.0f / 64.0f);
                const float c = __builtin_amdgcn_cosf(ph), s = __builtin_amdgcn_sinf(ph); val = (pp == p) ? c : (pp == 0 ? s : -s); }
            A2[e] = (bf16)f2bf(val * 0.125f); } } }
    { float* TWC = (float*)(ws + WS_TWC); float* TWS = (float*)(ws + WS_TWS);
      for (int e = gt; e < 128 * 64; e += NGT) { const int k1 = e >> 6, s2 = e & 63; const float ph = (float)(k1 * s2) * (1.0f / 8192.0f); TWC[e] = __builtin_amdgcn_cosf(ph); TWS[e] = __builtin_amdgcn_sinf(ph); } }
    { bf16* DTm = (bf16*)(ws + WS_DT);
      for (int e = gt; e < 128 * 256; e += NGT) { const int c2 = e >> 8, pp = (e >> 7) & 1, c = e & 127; const float ph = (float)((c * c2) & 127) * (1.0f / 128.0f);
          DTm[e] = (bf16)f2bf((pp ? __builtin_amdgcn_sinf(ph) : __builtin_amdgcn_cosf(ph)) * 0.125f); } }
    if (gw < DEPTH) { const int l = gw; float* lam = (float*)(ws + WS_LAM);
        const float a = wave_sum(argp->in[10][l * 64 + lane] * argp->in[11][l * 64 + lane]), b = wave_sum(argp->in[12][l * 64 + lane] * argp->in[13][l * 64 + lane]);
        if (lane == 0) lam[l] = __builtin_amdgcn_exp2f(a * 1.4426950408889634f) - __builtin_amdgcn_exp2f(b * 1.4426950408889634f) + argp->lam_init[l]; }
}

__device__ __forceinline__ int lane_id_fresh() { int l; asm volatile("v_mbcnt_lo_u32_b32 %0, -1, 0\n\tv_mbcnt_hi_u32_b32 %0, -1, %0" : "=v"(l)); return l; }
#define KARGS() KArgP ap = (KArgP)__builtin_amdgcn_kernarg_segment_ptr(); asm volatile("" : "+s"(ap)); unsigned char* const ws = ap->ws; (void)ws
#define GRID_BAR() do { KArgP ap_ = (KArgP)__builtin_amdgcn_kernarg_segment_ptr(); asm volatile("" : "+s"(ap_)); XcdBarrier b_; b_.bar = (unsigned*)(ap_->ws + WS_CTL) + CW_BAR; b_.x = xb_xcc_id(); \
    b_.st = (volatile LAS unsigned*)(lds + MISC_OFF) + 8; xcd_barrier(b_, MYTID() == 0); } while (0)
typedef pg8::bf16_t pb;
__global__ void __launch_bounds__(NWAVES * 64, 2) enc_fwd(Args args_unused) {
    extern __shared__ __attribute__((aligned(16))) unsigned char lds_raw[];
    LAS unsigned char* lds = (LAS unsigned char*)lds_raw;
    const int wave_s = __builtin_amdgcn_readfirstlane((int)threadIdx.x >> 6);
#define MYTID() ((wave_s << 6) | lane_id_fresh())
    const int G = gridDim.x; const int bx = blockIdx.x; const int vcu = (G % 8 == 0) ? (bx % 8) * (G / 8) + bx / 8 : bx;
    for (int u = threadIdx.x; u < (LDS_BYTES - LDSCTL_OFF) / 4; u += NWAVES * 64) ((LAS unsigned*)(lds + LDSCTL_OFF))[u] = 0u;
    __syncthreads();
    { KARGS(); (void)xcd_barrier_post((unsigned*)(ws + WS_CTL) + CW_BAR, (volatile LAS unsigned*)(lds + MISC_OFF) + 8, MYTID() == 0); }

    { KARGS(); const int tid = MYTID(); p0_prologue(ap, lds, vcu, G, wave_s, tid & 63); }
    GRID_BAR();

    for (int l = 0; l < DEPTH; ++l) {
        for (int f = 0; f < 2; ++f) {
            { KARGS(); pg8::Gemm g{(const pb*)(ws + WS_XB), (const pb*)(ws + WS_WGU + (size_t)(l * 2 + f) * SZ_WGU), SEQ, 2 * DFF, DM, DM, DM}; pg8::StaticOrder S; S.init(g.M, g.N, G, bx, GEMM_WGM); S.nlim = (S.nwg / G) * G;
              pg8::EpiSwiGLU<false> E{(pb*)(ws + WS_H), (const float*)(ws + WS_SSQ)};
              pg8::gemm_phase<pg8::EpiSwiGLU<false>, pg8::StaticOrder, true, true>(lds + RING_OFF, g, S, E, MYTID()); }
            { KARGS(); pg8::Gemm g{(const pb*)(ws + WS_XB), (const pb*)(ws + WS_WGU + (size_t)(l * 2 + f) * SZ_WGU), SEQ, 2 * DFF, DM, DM, DM}; pg8::TailHalves S; S.S.init(g.M, g.N, G, bx, GEMM_WGM); S.first = (S.S.nwg / G) * G;
              pg8::EpiSwiGLU<true> E{(pb*)(ws + WS_H), (const float*)(ws + WS_SSQ)};
              pg8::gemm_phase<pg8::EpiSwiGLU<true>, pg8::TailHalves, true, true, true>(lds + RING_OFF, g, S, E, MYTID()); }
            GRID_BAR();
            { KARGS(); pg8::Gemm g{(const pb*)(ws + WS_H), (const pb*)(ws + WS_WDN + (size_t)(l * 2 + f) * SZ_WDN), SEQ, DM, DFF, DFF, DFF}; pg8::StaticOrder S; S.init(g.M, g.N, G, bx, GEMM_WGM);
              const int wf_ = __builtin_amdgcn_readfirstlane((l == DEPTH - 1 && f == 1) ? 1 : 0); pg8::EpiResid E{(pb*)(ws + WS_XB), (float*)(ws + WS_SSQ), ap->out, 0.5f, wf_};
              pg8::gemm_phase<pg8::EpiResid, pg8::StaticOrder, true, true>(lds + RING_OFF, g, S, E, MYTID()); }
            if (l == DEPTH - 1 && f == 1) break;
            GRID_BAR();
            if (f == 0) {
                { KARGS(); pg8::Gemm g{(const pb*)(ws + WS_XB), (const pb*)(ws + WS_WIN + (size_t)l * SZ_WIN), SEQ, INW, DM, DM, DM}; pg8::StaticOrder S; S.init(g.M, g.N, G, bx, GEMM_WGM);
                  pg8::EpiWin E{(const float*)(ws + WS_SSQ), (pb*)(ws + WS_UT), (pb*)(ws + WS_Q), (pb*)(ws + WS_K), (pb*)(ws + WS_V), (const float*)(ws + WS_COS), (const float*)(ws + WS_SIN), ap->in[8] + l * 64, ap->in[9] + l * 64};
                  pg8::gemm_phase<pg8::EpiWin, pg8::StaticOrder, true, true, false, true>(lds + RING_OFF, g, S, E, MYTID()); }
                GRID_BAR();
                {
                { KARGS(); pg8::Gemm g{(const pb*)(ws + WS_A1), (const pb*)(ws + WS_UT), 256, 65536, 128, 128, 128}; pg8::StaticOrder S; S.init(g.M, g.N, G, bx, GEMM_WGM);
                  pg8::EpiFft1 E{(pb*)(ws + WS_O1T), (const float*)(ws + WS_TWC), (const float*)(ws + WS_TWS)};
                  pg8::gemm_phase<pg8::EpiFft1, pg8::StaticOrder, true, true>(lds + RING_OFF, g, S, E, MYTID()); }
                GRID_BAR();
#pragma unroll 1
                for (int r = 0; r * G < 512; ++r) { KARGS(); pg8::Gemm g{(const pb*)(ws + WS_A2), (const pb*)(ws + WS_O1T), 256, 131072, 128, 128, 128}; pg8::OneRound S; S.S.init(g.M, g.N, G, bx, GEMM_WGM); S.r = r;
                  pg8::EpiFft2 E{(pb*)(ws + WS_YA), (const pb*)(ws + WS_DT)};
                  pg8::gemm_phase<pg8::EpiFft2, pg8::OneRound, true, true>(lds + RING_OFF, g, S, E, MYTID()); }
                }
                { KARGS(); att::Tensors T{(const pb*)(ws + WS_Q), (const pb*)(ws + WS_K), (const pb*)(ws + WS_V), (pb*)(ws + WS_YA), (float*)(ws + WS_O0), ap->in[14] + l * 128, __builtin_amdgcn_readfirstlane(((const int*)(ws + WS_LAM))[l]), __builtin_bit_cast(int, ap->lam_init[l])};
                  for (int u = vcu; u < 256; u += G) att::attn_unit(u >> 5, u & 31, T, (char*)lds_raw + RING_OFF, lds + RING_OFF, MYTID()); }
                GRID_BAR();
                { KARGS(); pg8::Gemm g{(const pb*)(ws + WS_YA), (const pb*)(ws + WS_WOUT + (size_t)l * SZ_WOUT), SEQ, DM, DM, DM, DM}; pg8::StaticOrder S; S.init(g.M, g.N, G, bx, GEMM_WGM);
                  pg8::EpiResid E{(pb*)(ws + WS_XB), (float*)(ws + WS_SSQ), ap->out, 1.0f, 0};
                  pg8::gemm_phase<pg8::EpiResid, pg8::StaticOrder, true, true>(lds + RING_OFF, g, S, E, MYTID()); }
                GRID_BAR();
            }
        }
    }
}

extern "C" void kernel_launch(void* const* d_in, const int* in_sizes, int n_in, void* d_out, int out_size, void* d_ws, size_t ws_size, hipStream_t stream) {
    static int grid = 0;
    if (grid == 0) {
        if (n_in != 20 || in_sizes[0] != SEQ * DM || out_size != SEQ * DM || ws_size < WS_END) {
            fprintf(stderr, "kernel_launch: shape mismatch: n_in %d in0 %d out %d ws %zu (need >= %zu)\n", n_in, n_in > 0 ? in_sizes[0] : -1, out_size, ws_size, (size_t)WS_END); grid = -1; return; }
        int dev = 0, cus = 0, per_cu = 0;
        if (hipGetDevice(&dev) != hipSuccess || hipDeviceGetAttribute(&cus, hipDeviceAttributeMultiprocessorCount, dev) != hipSuccess) { fprintf(stderr, "kernel_launch: device query failed\n"); grid = -1; return; }
        if (hipFuncSetAttribute((const void*)enc_fwd, hipFuncAttributeMaxDynamicSharedMemorySize, LDS_BYTES) != hipSuccess) { fprintf(stderr, "kernel_launch: hipFuncSetAttribute failed\n"); grid = -1; return; }
        if (hipOccupancyMaxActiveBlocksPerMultiprocessor(&per_cu, (const void*)enc_fwd, NWAVES * 64, LDS_BYTES) != hipSuccess || per_cu < 1)
            fprintf(stderr, "kernel_launch: note: occupancy query reports %d workgroups per CU\n", per_cu);
        (void)hipGetLastError();
        grid = cus;
    }
    if (grid < 0) return;
    if (hipMemsetAsync((char*)d_ws + WS_CTL, 0, CTL_ZERO_BYTES, stream) != hipSuccess) { fprintf(stderr, "kernel_launch: memset failed\n"); return; }
    Args a{};
    for (int i = 0; i < 20; ++i) a.in[i] = (const float*)d_in[i];
    a.out = (float*)d_out; a.ws = (unsigned char*)d_ws;
    for (int l = 0; l < DEPTH; ++l) a.lam_init[l] = (float)(0.8 - 0.6 * exp(-0.3 * (double)l));
    hipLaunchKernelGGL(enc_fwd, dim3(grid), dim3(NWAVES * 64), LDS_BYTES, stream, a);
    const hipError_t le = hipGetLastError();
    if (le != hipSuccess) fprintf(stderr, "kernel_launch: launch failed: %s\n", hipGetErrorName(le));
}
```

```cpp
#include <hip/hip_runtime.h>
#include <cstdio>
#include <cstdint>
#include <cmath>
namespace pg8 {
#define PG8_LAS __attribute__((address_space(3)))
typedef unsigned short bf16_t;
typedef short bf16x8 __attribute__((ext_vector_type(8)));
typedef float f32x4 __attribute__((ext_vector_type(4)));
typedef unsigned u32x4 __attribute__((ext_vector_type(4)));
typedef unsigned u32x2 __attribute__((ext_vector_type(2)));
constexpr int BM = 256, BK = 64, HALF = 128, HTB = HALF * BK * 2  , STAGE_BYTES = 8 * HTB, NXCD = 8, WGM = 8;

__host__ __device__ __forceinline__ int lds_byte(int r, int c) { const int st = (r >> 4) * 2 + (c >> 5), rr = r & 15, cc = c & 31, ob = rr * 64 + cc * 2; return st * 1024 + (ob ^ (((ob >> 9) & 1) << 5)); }
__host__ __device__ __forceinline__ void stage_rc(int b, int& R, int& C) { const int st = b / 1024, sb = b % 1024, swz = sb ^ (((sb >> 9) & 1) << 5); R = (st >> 1) * 16 + swz / 64; C = (st & 1) * 32 + (swz % 64) / 2; }
__host__ __device__ __forceinline__ int perm32(int rho) { const int n = rho >> 4, i = rho & 15; return 8 * (i >> 2) + 4 * n + (i & 3); }

struct Unit { int pm, pn; };
struct Gemm { const bf16_t* A; const bf16_t* Bt; int M, N, K, lda, ldb; };

struct StaticOrder {
    int nM, nN, nwg, G, c, wgm, nlim;
    __host__ __device__ void init(int M, int N, int G_, int c_, int wgm_ = WGM) { nM = M / BM; nN = N / BM; nwg = nM * nN; G = G_; c = c_; wgm = wgm_; nlim = nwg; }
    __host__ __device__ void unit_of(int L, Unit& u) const {
        int wgid = L; { const int q = nwg / NXCD, r = nwg % NXCD, xcd = wgid % NXCD, off = wgid / NXCD; wgid = (xcd < r ? xcd * (q + 1) : r * (q + 1) + (xcd - r) * q) + off; }
        const int nig = wgm * nN, gid = wgid / nig, fm = gid * wgm, gsz = (nM - fm) < wgm ? (nM - fm) : wgm;
        u.pm = fm + ((wgid % nig) % gsz); u.pn = (wgid % nig) / gsz;
    }
    __host__ __device__ bool next(int i, Unit& u) const {
        const long L = (long)i * G + c; if (L >= nlim) return false;
        unit_of((int)L, u); return true;
    }
    __device__ __forceinline__ void a_ready(const Unit&) const {}
    __device__ __forceinline__ void done(const Unit&) const {}
};
struct TailHalves {
    StaticOrder S; int first;
    __host__ __device__ bool next(int i, Unit& u) const { const int ntail = S.nwg - first; const long j = (long)i * S.G + S.c; if (j >= 2 * ntail) return false;
        S.unit_of(first + (int)(j % ntail), u); u.pm = 2 * u.pm + (int)(j / ntail); return true; }
    __device__ __forceinline__ void a_ready(const Unit&) const {}
    __device__ __forceinline__ void done(const Unit&) const {}
};
struct OneRound {
    StaticOrder S; int r;
    __host__ __device__ bool next(int i, Unit& u) const { return i == 0 && S.next(r, u); }
    __device__ __forceinline__ void a_ready(const Unit&) const {}
    __device__ __forceinline__ void done(const Unit&) const {}
};

__device__ __forceinline__ unsigned cvt_pk_bf16(float lo, float hi) { unsigned r; asm volatile("v_cvt_pk_bf16_f32 %0, %1, %2" : "=v"(r) : "v"(lo), "v"(hi)); return r; }
typedef float f32x2 __attribute__((ext_vector_type(2)));
template <int CTRL> __device__ __forceinline__ float dpp_f(float v) { return __builtin_bit_cast(float, __builtin_amdgcn_update_dpp(0, __builtin_bit_cast(int, v), CTRL, 0xF, 0xF, true)); }
__device__ __forceinline__ float sum8(float v) { v += dpp_f<0xB1>(v); v += dpp_f<0x4E>(v); v += dpp_f<0x141>(v); return v; }
__device__ __forceinline__ float sum_xor16(float v) { float a = v, b = v; asm volatile("s_nop 1\n\tv_permlane16_swap_b32 %0, %1" : "+v"(a), "+v"(b)); return a + b; }
__device__ __forceinline__ float sum_xor32(float v) { float a = v, b = v; asm volatile("s_nop 1\n\tv_permlane32_swap_b32 %0, %1" : "+v"(a), "+v"(b)); return a + b; }
__device__ __forceinline__ float sum_fq(float s) { return sum_xor32(sum_xor16(s)); }
__device__ __forceinline__ int opaque0() { int z; asm volatile("v_mov_b32 %0, 0" : "=v"(z)); return z; }
template <bool TOK = false> __device__ __forceinline__ void rows_rstd(float (&rs)[8], const float* ssq, int row0, int fq) {
    f32x4 pa[8], pb[8];
#pragma unroll
    for (int i = 0; i < 8; ++i) { const f32x4* p = (const f32x4*)(ssq + (size_t)(TOK ? row0 + 64 * i : row0 + (i >> 2) * HALF + (i & 3) * 16) * 32 + fq * 8); pa[i] = p[0]; pb[i] = p[1]; }
    __builtin_amdgcn_sched_barrier(0);
#pragma unroll
    for (int i = 0; i < 8; ++i) { const f32x4 a = pa[i], b = pb[i]; float s = ((a[0] + a[1]) + (a[2] + a[3])) + ((b[0] + b[1]) + (b[2] + b[3])); s = sum_fq(s); rs[i] = 1.0f / sqrtf(s * (1.0f / 2048.0f) + 1e-6f); }
}
__device__ __forceinline__ float row_rstd(const float* ssq, int row) {
    const f32x4* p = (const f32x4*)(ssq + (size_t)row * 32); f32x4 v[8];
#pragma unroll
    for (int i = 0; i < 8; ++i) v[i] = p[i];
    float s = 0.f;
#pragma unroll
    for (int i = 0; i < 8; ++i) s += (v[i][0] + v[i][1]) + (v[i][2] + v[i][3]);
    return 1.0f / sqrtf(s * (1.0f / 2048.0f) + 1e-6f);
}
__device__ __forceinline__ float silu_mul(float g, float u) { const float e = __builtin_amdgcn_exp2f(g * -1.4426950408889634f); return g * u * __builtin_amdgcn_rcpf(1.0f + e); }

struct EpiStore {
    static constexpr bool PERM = true, AFTER_DRAIN = false, RSTD = false;
    bf16_t* O; int ldc;
    __device__ __forceinline__ void operator()(const f32x4 (&acc)[2][2][4][2], const Unit& u, int wr, int wc, int fr, int fq) const {
        const int z = opaque0(); const int row0 = u.pm * BM + wr * 64 + fr + z, col0 = u.pn * BM + wc * 32 + 8 * fq + z;
#pragma unroll
        for (int ai = 0; ai < 2; ++ai)
#pragma unroll
            for (int m = 0; m < 4; ++m) { bf16_t* rowp = O + (size_t)(row0 + ai * HALF + m * 16) * ldc + col0;
#pragma unroll
                for (int bj = 0; bj < 2; ++bj) { const f32x4 v0 = acc[ai][bj][m][0], v1 = acc[ai][bj][m][1];
                    u32x4 w; w.x = cvt_pk_bf16(v0[0], v0[1]); w.y = cvt_pk_bf16(v0[2], v0[3]); w.z = cvt_pk_bf16(v1[0], v1[1]); w.w = cvt_pk_bf16(v1[2], v1[3]);
                    *(u32x4*)(rowp + bj * HALF) = w; } }
    }
};
template <bool HALFM> struct EpiSwiGLU {
    static constexpr bool PERM = true, AFTER_DRAIN = false, RSTD = true;
    bf16_t* H; const float* ssq;
    __device__ __forceinline__ void prime(PG8_LAS float* rc, const Unit& u, int tid) const {
        if (tid < (HALFM ? HALF : BM)) rc[tid] = row_rstd(ssq, u.pm * (HALFM ? HALF : BM) + tid);
        asm volatile("s_waitcnt lgkmcnt(0)" ::: "memory");
    }
    __device__ __forceinline__ void operator()(const f32x4 (&acc)[2][2][4][2], const Unit& u, int wr, int wc, int fr, int fq, const PG8_LAS float* rc, bool cached) const {
        const int z = opaque0(); const int row0 = u.pm * (HALFM ? HALF : BM) + wr * 64 + fr + z, col0 = u.pn * HALF + wc * 32 + 8 * fq + z;
        float rsv[8];
        if (cached) {
#pragma unroll
            for (int i = 0; i < (HALFM ? 4 : 8); ++i) rsv[i] = rc[(i >> 2) * HALF + wr * 64 + (i & 3) * 16 + fr + z];
        } else rows_rstd<false>(rsv, ssq, row0, fq);
#pragma unroll
        for (int ai = 0; ai < (HALFM ? 1 : 2); ++ai)
#pragma unroll
            for (int m = 0; m < 4; ++m) { const int row = row0 + ai * HALF + m * 16; const float rs = rsv[ai * 4 + m];
                const f32x4 g0 = acc[ai][0][m][0] * rs, g1 = acc[ai][0][m][1] * rs, u0 = acc[ai][1][m][0] * rs, u1 = acc[ai][1][m][1] * rs;
                u32x4 w; w.x = cvt_pk_bf16(silu_mul(g0[0], u0[0]), silu_mul(g0[1], u0[1])); w.y = cvt_pk_bf16(silu_mul(g0[2], u0[2]), silu_mul(g0[3], u0[3]));
                w.z = cvt_pk_bf16(silu_mul(g1[0], u1[0]), silu_mul(g1[1], u1[1])); w.w = cvt_pk_bf16(silu_mul(g1[2], u1[2]), silu_mul(g1[3], u1[3]));
                *(u32x4*)(H + (size_t)row * 5632 + col0) = w; }
    }
};
struct EpiResid {
    static constexpr bool PERM = true, AFTER_DRAIN = false, RSTD = false;
    bf16_t* xb; float* ssq; float* fout; float alpha; int wf;
    __device__ __forceinline__ void operator()(const f32x4 (&acc)[2][2][4][2], const Unit& u, int wr, int wc, int fr, int fq) const {
        const int z = opaque0(); const int row0 = u.pm * BM + wr * 64 + fr + z, col0 = u.pn * BM + wc * 32 + 8 * fq + z;
#pragma unroll
        for (int ai = 0; ai < 2; ++ai) {
            u32x4 rb[4][2];
#pragma unroll
            for (int m = 0; m < 4; ++m) { const size_t off = (size_t)(row0 + ai * HALF + m * 16) * 2048 + col0;
#pragma unroll
                for (int bj = 0; bj < 2; ++bj) rb[m][bj] = *(const u32x4*)(xb + off + bj * HALF); }
            __builtin_amdgcn_sched_barrier(0);
#pragma unroll
            for (int m = 0; m < 4; ++m) { const int row = row0 + ai * HALF + m * 16; const size_t off = (size_t)row * 2048 + col0; float sq = 0.f;
#pragma unroll
                for (int bj = 0; bj < 2; ++bj) { const u32x4 r = rb[m][bj];
                    const f32x4 b0 = (f32x4){__builtin_bit_cast(float, r.x << 16), __builtin_bit_cast(float, r.x & 0xffff0000u), __builtin_bit_cast(float, r.y << 16), __builtin_bit_cast(float, r.y & 0xffff0000u)};
                    const f32x4 b1 = (f32x4){__builtin_bit_cast(float, r.z << 16), __builtin_bit_cast(float, r.z & 0xffff0000u), __builtin_bit_cast(float, r.w << 16), __builtin_bit_cast(float, r.w & 0xffff0000u)};
                    const f32x4 o0 = b0 + acc[ai][bj][m][0] * alpha, o1 = b1 + acc[ai][bj][m][1] * alpha;
                    if (wf) { *(f32x4*)(fout + off + bj * HALF) = o0; *(f32x4*)(fout + off + bj * HALF + 4) = o1; }
                    sq += (o0[0] * o0[0] + o0[1] * o0[1]) + (o0[2] * o0[2] + o0[3] * o0[3]) + (o1[0] * o1[0] + o1[1] * o1[1]) + (o1[2] * o1[2] + o1[3] * o1[3]);
                    u32x4 w; w.x = cvt_pk_bf16(o0[0], o0[1]); w.y = cvt_pk_bf16(o0[2], o0[3]); w.z = cvt_pk_bf16(o1[0], o1[1]); w.w = cvt_pk_bf16(o1[2], o1[3]);
                    *(u32x4*)(xb + off + bj * HALF) = w; }
                sq = sum_fq(sq);
                if (fq == 0) ssq[(size_t)row * 32 + u.pn * 4 + wc] = sq; }
            __builtin_amdgcn_sched_barrier(0); }
    }
};
struct EpiWin {
    static constexpr bool PERM = true, AFTER_DRAIN = false, RSTD = true;
    const float* ssq; bf16_t* UT; bf16_t* Qb; bf16_t* Kb; bf16_t* Vb; const float* cosT; const float* sinT; const float* gq; const float* gk;
    __device__ __forceinline__ void prime(PG8_LAS float* rc, const Unit& u, int tid) const {
        if (tid < BM) { const int ai = tid >> 7, wr_ = (tid >> 6) & 1, m = (tid >> 4) & 3, fr_ = tid & 15; rc[tid] = row_rstd(ssq, 512 * (u.pm & 15) + 32 * (u.pm >> 4) + 64 * (4 * ai + m) + 16 * wr_ + fr_); }
        asm volatile("s_waitcnt lgkmcnt(0)" ::: "memory");
    }
    __device__ __forceinline__ void operator()(const f32x4 (&acc)[2][2][4][2], const Unit& u, int wr, int wc, int fr, int fq, const PG8_LAS float* rc, bool cached) const {
        const int z = opaque0(); fq += z; const int b1 = u.pm & 15; const int tok0 = 512 * b1 + 32 * (u.pm >> 4) + 16 * wr + fr + z; const int sec = u.pn >> 2;
        float rsv[8];
        if (cached) {
#pragma unroll
            for (int i = 0; i < 8; ++i) rsv[i] = rc[(i >> 2) * HALF + wr * 64 + (i & 3) * 16 + fr + z];
        } else rows_rstd<true>(rsv, ssq, tok0, fq);
        if (sec == 0) {
            const int s2 = tok0 & 63;
#pragma unroll
            for (int bj = 0; bj < 2; ++bj)
#pragma unroll
                for (int n = 0; n < 2; ++n)
#pragma unroll
                    for (int e = 0; e < 4; ++e) { const int col = (u.pn & 3) * BM + bj * HALF + wc * 32 + 8 * fq + 4 * n + e;
                        u32x4 w; w.x = cvt_pk_bf16(acc[0][bj][0][n][e] * rsv[0], acc[0][bj][1][n][e] * rsv[1]); w.y = cvt_pk_bf16(acc[0][bj][2][n][e] * rsv[2], acc[0][bj][3][n][e] * rsv[3]);
                        w.z = cvt_pk_bf16(acc[1][bj][0][n][e] * rsv[4], acc[1][bj][1][n][e] * rsv[5]); w.w = cvt_pk_bf16(acc[1][bj][2][n][e] * rsv[6], acc[1][bj][3][n][e] * rsv[7]);
                        *(u32x4*)(UT + ((size_t)(col * 64 + s2) * 128 + 8 * b1)) = w; }
        } else if (sec == 3) {
            const int col0 = (u.pn & 3) * BM + wc * 32 + 8 * fq;
#pragma unroll
            for (int ai = 0; ai < 2; ++ai)
#pragma unroll
                for (int m = 0; m < 4; ++m) { const int row = tok0 + 64 * (ai * 4 + m); const float rs = rsv[ai * 4 + m];
#pragma unroll
                    for (int bj = 0; bj < 2; ++bj) { const f32x4 v0 = acc[ai][bj][m][0] * rs, v1 = acc[ai][bj][m][1] * rs;
                        u32x4 w; w.x = cvt_pk_bf16(v0[0], v0[1]); w.y = cvt_pk_bf16(v0[2], v0[3]); w.z = cvt_pk_bf16(v1[0], v1[1]); w.w = cvt_pk_bf16(v1[2], v1[3]);
                        *(u32x4*)(Vb + (size_t)row * 1024 + col0 + bj * HALF) = w; } }
        } else {
            const bool isq = sec == 1; const float* gv = isq ? gq : gk; bf16_t* dst = isq ? Qb : Kb; const float osc = isq ? 0.125f * 1.4426950408889634f : 1.0f;
            const int vec = (u.pn & 3) * 4 + wc;
            const f32x4 ga0 = *(const f32x4*)(gv + 8 * fq), ga1 = *(const f32x4*)(gv + 8 * fq + 4), gb0 = *(const f32x4*)(gv + 32 + 8 * fq), gb1 = *(const f32x4*)(gv + 32 + 8 * fq + 4);
#pragma unroll
            for (int ah = 0; ah < 4; ++ah) { const int ai = ah >> 1, mh = (ah & 1) * 2;
                f32x4 cs[2][4];
#pragma unroll
                for (int mm = 0; mm < 2; ++mm) { const int m = mh + mm; const size_t ro = (size_t)(tok0 + 64 * (ai * 4 + m)) * 32 + 8 * fq;
                    cs[mm][0] = *(const f32x4*)(cosT + ro); cs[mm][1] = *(const f32x4*)(cosT + ro + 4); cs[mm][2] = *(const f32x4*)(sinT + ro); cs[mm][3] = *(const f32x4*)(sinT + ro + 4); }
                __builtin_amdgcn_sched_barrier(0);
#pragma unroll
                for (int mm = 0; mm < 2; ++mm) { const int m = mh + mm; const int row = tok0 + 64 * (ai * 4 + m); const float rs = rsv[ai * 4 + m];
                    f32x4 a0 = acc[ai][0][m][0] * rs, a1 = acc[ai][0][m][1] * rs, b0 = acc[ai][1][m][0] * rs, b1v = acc[ai][1][m][1] * rs;
                    float sq = (a0[0] * a0[0] + a0[1] * a0[1]) + (a0[2] * a0[2] + a0[3] * a0[3]) + (a1[0] * a1[0] + a1[1] * a1[1]) + (a1[2] * a1[2] + a1[3] * a1[3])
                             + (b0[0] * b0[0] + b0[1] * b0[1]) + (b0[2] * b0[2] + b0[3] * b0[3]) + (b1v[0] * b1v[0] + b1v[1] * b1v[1]) + (b1v[2] * b1v[2] + b1v[3] * b1v[3]);
                    sq = sum_fq(sq);
                    const float rn = 1.0f / sqrtf(sq * (1.0f / 64.0f) + 1e-6f);
                    a0 = a0 * rn * ga0; a1 = a1 * rn * ga1; b0 = b0 * rn * gb0; b1v = b1v * rn * gb1;
                    const f32x4 c0 = cs[mm][0], c1 = cs[mm][1], s0 = cs[mm][2], s1 = cs[mm][3];
                    const f32x4 lo0 = (a0 * c0 - b0 * s0) * osc, lo1 = (a1 * c1 - b1v * s1) * osc, hi0 = (b0 * c0 + a0 * s0) * osc, hi1 = (b1v * c1 + a1 * s1) * osc;
                    u32x4 w; w.x = cvt_pk_bf16(lo0[0], lo0[1]); w.y = cvt_pk_bf16(lo0[2], lo0[3]); w.z = cvt_pk_bf16(lo1[0], lo1[1]); w.w = cvt_pk_bf16(lo1[2], lo1[3]);
                    *(u32x4*)(dst + (size_t)row * 1024 + vec * 64 + 8 * fq) = w;
                    w.x = cvt_pk_bf16(hi0[0], hi0[1]); w.y = cvt_pk_bf16(hi0[2], hi0[3]); w.z = cvt_pk_bf16(hi1[0], hi1[1]); w.w = cvt_pk_bf16(hi1[2], hi1[3]);
                    *(u32x4*)(dst + (size_t)row * 1024 + vec * 64 + 32 + 8 * fq) = w; }
                __builtin_amdgcn_sched_barrier(0); }
        }
    }
};
struct EpiFft1 {
    static constexpr bool PERM = true, AFTER_DRAIN = false, RSTD = false;
    bf16_t* O1T; const float* TWC; const float* TWS;
    __device__ __forceinline__ void operator()(const f32x4 (&acc)[2][2][4][2], const Unit& u, int wr, int wc, int fr, int fq) const {
        const int z = opaque0(); fr += z; const int s2 = 32 * (wc & 1) + 8 * fq + z;
#pragma unroll
        for (int m = 0; m < 4; ++m) { const int k1 = wr * 64 + m * 16 + fr;
            const f32x4 c0 = *(const f32x4*)(TWC + k1 * 64 + s2), c1 = *(const f32x4*)(TWC + k1 * 64 + s2 + 4), s0 = *(const f32x4*)(TWS + k1 * 64 + s2), s1 = *(const f32x4*)(TWS + k1 * 64 + s2 + 4);
#pragma unroll
            for (int bj = 0; bj < 2; ++bj) { const int col = 4 * u.pn + 2 * bj + (wc >> 1);
                const f32x4 r0 = acc[0][bj][m][0], r1 = acc[0][bj][m][1], i0 = acc[1][bj][m][0], i1 = acc[1][bj][m][1];
                const f32x4 or0 = r0 * c0 + i0 * s0, or1 = r1 * c1 + i1 * s1, oi0 = i0 * c0 - r0 * s0, oi1 = i1 * c1 - r1 * s1;
                bf16_t* dst = O1T + ((size_t)k1 * 1024 + col) * 128 + s2;
                u32x4 w; w.x = cvt_pk_bf16(or0[0], or0[1]); w.y = cvt_pk_bf16(or0[2], or0[3]); w.z = cvt_pk_bf16(or1[0], or1[1]); w.w = cvt_pk_bf16(or1[2], or1[3]);
                *(u32x4*)dst = w;
                w.x = cvt_pk_bf16(oi0[0], oi0[1]); w.y = cvt_pk_bf16(oi0[2], oi0[3]); w.z = cvt_pk_bf16(oi1[0], oi1[1]); w.w = cvt_pk_bf16(oi1[2], oi1[3]);
                *(u32x4*)(dst + 64) = w; }
            asm volatile("" ::: "memory"); }
    }
};
struct EpiFft2 {
    static constexpr bool PERM = true, AFTER_DRAIN = true, RSTD = false;
    bf16_t* YA; const bf16_t* DT;
    static __device__ __forceinline__ unsigned pk_rne(float lo, float hi) { unsigned a = __builtin_bit_cast(unsigned, lo), b = __builtin_bit_cast(unsigned, hi);
        a = (a + 0x7fffu + ((a >> 16) & 1u)) >> 16; b = (b + 0x7fffu + ((b >> 16) & 1u)) & 0xffff0000u; return a | b; }
    static constexpr int XP = 528, XG = 64 * XP;
    __device__ __forceinline__ void fused(const f32x4 (&acc)[2][2][4][2], const Unit& u, int wr, int wc, int fr, int fq, PG8_LAS unsigned char* lds, int wid, int lane) const {
        typedef __attribute__((ext_vector_type(16))) float f32x16;
        const int k1 = u.pn >> 2;
#pragma unroll
        for (int m = 0; m < 4; ++m)
#pragma unroll
            for (int bj = 0; bj < 2; ++bj) { const f32x4 v0 = acc[0][bj][m][0], v1 = acc[0][bj][m][1];
                u32x4 w; w.x = cvt_pk_bf16(v0[0], v0[1]); w.y = cvt_pk_bf16(v0[2], v0[3]); w.z = cvt_pk_bf16(v1[0], v1[1]); w.w = cvt_pk_bf16(v1[2], v1[3]);
                *(PG8_LAS u32x4*)(lds + bj * XG + (m * 16 + fr) * XP + (wr * 128 + wc * 32 + 8 * fq) * 2) = w; }
        asm volatile("s_waitcnt lgkmcnt(0)\n\ts_barrier" ::: "memory");
        const int g2 = wid >> 2, cq = wid & 3, r32 = lane & 31, hi = lane >> 5;
        const bf16_t* dtp = DT + (32 * cq + r32) * 256 + 8 * hi;
        const PG8_LAS unsigned char* xp = lds + g2 * XG + r32 * XP + 16 * hi;
        f32x16 y0 = {}, y1 = {};
#pragma unroll
        for (int kh = 0; kh < 2; ++kh) { bf16x8 a[8];
#pragma unroll
            for (int ks = 0; ks < 8; ++ks) a[ks] = *(const bf16x8*)(dtp + 16 * (8 * kh + ks));
#pragma unroll
            for (int ks = 0; ks < 8; ++ks) { const bf16x8 b0 = *(const PG8_LAS bf16x8*)(xp + 32 * (8 * kh + ks)), b1 = *(const PG8_LAS bf16x8*)(xp + 32 * XP + 32 * (8 * kh + ks));
                y0 = __builtin_amdgcn_mfma_f32_32x32x16_bf16(a[ks], b0, y0, 0, 0, 0); y1 = __builtin_amdgcn_mfma_f32_32x32x16_bf16(a[ks], b1, y1, 0, 0, 0); } }
        bf16_t* yb = YA + (size_t)(k1 + 128 * r32) * 2048 + (2 * (u.pn & 3) + g2) * 128 + 32 * cq + 4 * hi;
#pragma unroll
        for (int q = 0; q < 4; ++q) {
            u32x2 w0; w0.x = pk_rne(y0[4 * q], y0[4 * q + 1]); w0.y = pk_rne(y0[4 * q + 2], y0[4 * q + 3]); *(u32x2*)(yb + 8 * q) = w0;
            u32x2 w1; w1.x = pk_rne(y1[4 * q], y1[4 * q + 1]); w1.y = pk_rne(y1[4 * q + 2], y1[4 * q + 3]); *(u32x2*)(yb + (size_t)(128 * 32) * 2048 + 8 * q) = w1; }
        asm volatile("s_waitcnt lgkmcnt(0)\n\ts_barrier" ::: "memory");
    }
};
template <class Epi, class Sched, bool ALIGN_EPI = false, bool SP2 = false, bool HALFM = false, bool AMAP = false>
__device__ __forceinline__ void gemm_phase(PG8_LAS unsigned char* lds, const Gemm g, const Sched& S, const Epi& E, int tid_in) {
    int tid_ = tid_in; const char* gA = (const char*)g.A; const char* gB = (const char*)g.Bt;
    asm volatile("" : "+v"(tid_), "+s"(gA), "+s"(gB));
    const int tid = tid_, wid = __builtin_amdgcn_readfirstlane(tid >> 6), lane = tid & 63, wr = wid >> 2, wc = wid & 3, fr = lane & 15, fq = lane >> 4;
    static_assert(!HALFM || SP2, "HALFM is implemented for the SP2 loop only");
    const int K = g.K, nt = K / BK;
    unsigned voffA[2], voffB[2];
#pragma unroll
    for (int i = 0; i < 2; ++i) { int R, C; stage_rc(tid * 16 + i * 8192, R, C); const int Rb = Epi::PERM ? ((R & ~31) + perm32(R & 31)) : R;
        const int Ra = AMAP ? (64 * ((R >> 4) & 3) + 16 * (R >> 6) + (R & 15)) : R;
        voffA[i] = (unsigned)(Ra * g.lda + C) * 2u; voffB[i] = (unsigned)(Rb * g.ldb + C) * 2u; }
    const size_t kstep = (size_t)(BK * 2);
    const size_t hstepA = (size_t)(AMAP ? 256 : HALF) * g.lda * 2, hstepB = (size_t)HALF * g.ldb * 2;
    const size_t tstepA = HALFM ? hstepA : 2 * hstepA, tstepB = 2 * hstepB;
    const unsigned ldsw = (unsigned)wid * 1024u;
    const int aoff = lds_byte(wr * 64 + fr, fq * 8), boff = lds_byte(wc * 32 + fr, fq * 8);
#define PG8_SA(b, h) (((b) * 2 + (h)) * HTB)
#define PG8_SB(b, h) ((4 + (b) * 2 + (h)) * HTB)
#define PG8_STAGE(bufoff, gbase, voff) do { _Pragma("unroll") for (int _i = 0; _i < 2; ++_i) \
        __builtin_amdgcn_global_load_lds((const unsigned*)((const char*)(gbase) + (voff)[_i]), (PG8_LAS unsigned*)(lds + (bufoff) + ldsw + _i * 8192), 16, 0, 0); } while (0)
#define PG8_LDA(dst, b, h) do { _Pragma("unroll") for (int m = 0; m < 4; ++m) _Pragma("unroll") for (int k = 0; k < 2; ++k) dst[m][k] = *(const PG8_LAS bf16x8*)(lds + PG8_SA(b, h) + aoff + m * 2048 + k * 1024); } while (0)
#define PG8_LDB(dst, b, h) do { _Pragma("unroll") for (int n = 0; n < 2; ++n) _Pragma("unroll") for (int k = 0; k < 2; ++k) dst[n][k] = *(const PG8_LAS bf16x8*)(lds + PG8_SB(b, h) + boff + n * 2048 + k * 1024); } while (0)
#define PG8_MMA(ai, bj, At, Bt) do { __builtin_amdgcn_s_setprio(1); _Pragma("unroll") for (int m = 0; m < 4; ++m) _Pragma("unroll") for (int n = 0; n < 2; ++n) _Pragma("unroll") for (int k = 0; k < 2; ++k) \
        acc[ai][bj][m][n] = __builtin_amdgcn_mfma_f32_16x16x32_bf16(Bt[n][k], At[m][k], acc[ai][bj][m][n], 0, 0, 0); __builtin_amdgcn_s_setprio(0); } while (0)
#define PG8_WAIT_V(n) asm volatile("s_waitcnt vmcnt(" #n ")" ::: "memory")
#define PG8_WAIT_L(n) asm volatile("s_waitcnt lgkmcnt(" #n ")" ::: "memory")
#define PG8_WAIT_VK do { if constexpr (HALFM) PG8_WAIT_V(6); else PG8_WAIT_V(8); } while (0)
#define PG8_BAR __builtin_amdgcn_s_barrier()
#define PG8_SCHED __builtin_amdgcn_sched_barrier(0)
    Unit cur, nxt; int ui = 0;
    if (!S.next(0, cur)) return;
    const int pm0 = cur.pm;
    f32x4 acc[2][2][4][2];
#pragma unroll
    for (int a = 0; a < 2; ++a)
#pragma unroll
        for (int b = 0; b < 2; ++b)
#pragma unroll
            for (int m = 0; m < 4; ++m)
#pragma unroll
                for (int n = 0; n < 2; ++n) acc[a][b][m][n] = (f32x4){0.f, 0.f, 0.f, 0.f};
    bf16x8 At[4][2], B0[2][2], B1[2][2];
#define PG8_ATILE(pm_) (AMAP ? (size_t)(512 * ((pm_) & 15) + 32 * ((pm_) >> 4)) * g.lda * 2 : (size_t)(pm_) * tstepA)
    const char* cA = gA + PG8_ATILE(cur.pm); const char* cB = gB + (size_t)cur.pn * tstepB;
    S.a_ready(cur);
    if constexpr (SP2) {
        PG8_STAGE(PG8_SB(0, 0), cB, voffB); PG8_STAGE(PG8_SB(0, 1), cB + hstepB, voffB); PG8_STAGE(PG8_SA(0, 0), cA, voffA); if constexpr (!HALFM) PG8_STAGE(PG8_SA(0, 1), cA + hstepA, voffA);
        if constexpr (Epi::RSTD) E.prime((PG8_LAS float*)(lds + STAGE_BYTES), cur, tid);
        if (wr == 1) PG8_BAR;
        if constexpr (HALFM) PG8_WAIT_V(0); else PG8_WAIT_V(2);
        PG8_BAR;
        PG8_STAGE(PG8_SB(1, 0), cB + kstep, voffB); PG8_STAGE(PG8_SA(1, 0), cA + kstep, voffA); PG8_STAGE(PG8_SB(1, 1), cB + hstepB + kstep, voffB);
        PG8_WAIT_V(6); PG8_BAR;
    } else {
        PG8_STAGE(PG8_SB(0, 0), cB, voffB); PG8_STAGE(PG8_SA(0, 0), cA, voffA); PG8_STAGE(PG8_SB(0, 1), cB + hstepB, voffB); PG8_STAGE(PG8_SA(0, 1), cA + hstepA, voffA);
        if constexpr (Epi::RSTD) E.prime((PG8_LAS float*)(lds + STAGE_BYTES), cur, tid);
        if (wr == 1) PG8_BAR;
        PG8_WAIT_V(4); PG8_BAR;
        PG8_STAGE(PG8_SB(1, 0), cB + kstep, voffB); PG8_STAGE(PG8_SA(1, 0), cA + kstep, voffA); PG8_STAGE(PG8_SB(1, 1), cB + hstepB + kstep, voffB);
        PG8_WAIT_V(6); PG8_BAR;
    }
    for (;;) {
        const bool has_next = S.next(ui + 1, nxt);
        const char* nA = has_next ? gA + PG8_ATILE(nxt.pm) : cA + (size_t)(nt - 2) * kstep; const char* nB = has_next ? gB + (size_t)nxt.pn * tstepB : cB + (size_t)(nt - 2) * kstep;
        for (int t = 0; t < nt; t += 2) {
            const bool last = (t == nt - 2);
            const char* a1 = cA + (size_t)(t + 1) * kstep;
            const char* a2 = last ? nA : cA + (size_t)(t + 2) * kstep; const char* b2 = last ? nB : cB + (size_t)(t + 2) * kstep;
            const char* a3 = a2 + kstep; const char* b3 = b2 + kstep;
            if (last && has_next) S.a_ready(nxt);
            if constexpr (SP2) {
            PG8_LDB(B0, 0, 0); PG8_LDB(B1, 0, 1); PG8_SCHED; PG8_LDA(At, 0, 0); if constexpr (!HALFM) PG8_STAGE(PG8_SA(1, 1), a1 + hstepA, voffA);
            PG8_WAIT_VK; PG8_WAIT_L(0); PG8_BAR; PG8_MMA(0, 0, At, B0); PG8_MMA(0, 1, At, B1); PG8_BAR; PG8_SCHED;
            if constexpr (!HALFM) { PG8_LDA(At, 0, 1); } PG8_STAGE(PG8_SB(0, 0), b2, voffB); PG8_STAGE(PG8_SB(0, 1), b2 + hstepB, voffB); PG8_STAGE(PG8_SA(0, 0), a2, voffA);
            PG8_WAIT_VK; PG8_WAIT_L(0); PG8_BAR; if constexpr (!HALFM) { PG8_MMA(1, 0, At, B0); PG8_MMA(1, 1, At, B1); } PG8_BAR; PG8_SCHED;
            PG8_LDB(B0, 1, 0); PG8_LDB(B1, 1, 1); PG8_SCHED; PG8_LDA(At, 1, 0); if constexpr (!HALFM) PG8_STAGE(PG8_SA(0, 1), a2 + hstepA, voffA);
            PG8_WAIT_VK; PG8_WAIT_L(0); PG8_BAR; PG8_MMA(0, 0, At, B0); PG8_MMA(0, 1, At, B1); PG8_BAR; PG8_SCHED;
            if constexpr (!HALFM) { PG8_LDA(At, 1, 1); } PG8_STAGE(PG8_SB(1, 0), b3, voffB); PG8_STAGE(PG8_SB(1, 1), b3 + hstepB, voffB); PG8_STAGE(PG8_SA(1, 0), a3, voffA);
            PG8_WAIT_VK; PG8_WAIT_L(0); PG8_BAR; if constexpr (!HALFM) { PG8_MMA(1, 0, At, B0); PG8_MMA(1, 1, At, B1); } PG8_BAR; PG8_SCHED;
            } else {
            PG8_LDB(B0, 0, 0); PG8_SCHED; PG8_LDA(At, 0, 0); PG8_STAGE(PG8_SA(1, 1), a1 + hstepA, voffA);
            PG8_WAIT_L(8); PG8_BAR; PG8_WAIT_L(0); PG8_MMA(0, 0, At, B0); PG8_BAR; PG8_SCHED;
            PG8_LDB(B1, 0, 1); PG8_STAGE(PG8_SB(0, 0), b2, voffB);
            PG8_BAR; PG8_WAIT_L(0); PG8_MMA(0, 1, At, B1); PG8_BAR;
            PG8_LDA(At, 0, 1); PG8_STAGE(PG8_SA(0, 0), a2, voffA);
            PG8_BAR; PG8_WAIT_L(0); PG8_MMA(1, 0, At, B0); PG8_BAR; PG8_SCHED;
            PG8_STAGE(PG8_SB(0, 1), b2 + hstepB, voffB);
            PG8_WAIT_V(6); PG8_BAR; PG8_MMA(1, 1, At, B1); PG8_BAR;
            PG8_LDB(B0, 1, 0); PG8_SCHED; PG8_LDA(At, 1, 0); PG8_STAGE(PG8_SA(0, 1), a2 + hstepA, voffA);
            PG8_WAIT_L(8); PG8_BAR; PG8_WAIT_L(0); PG8_MMA(0, 0, At, B0); PG8_BAR; PG8_SCHED;
            PG8_LDB(B1, 1, 1); PG8_STAGE(PG8_SB(1, 0), b3, voffB);
            PG8_BAR; PG8_WAIT_L(0); PG8_MMA(0, 1, At, B1); PG8_BAR;
            PG8_LDA(At, 1, 1); PG8_STAGE(PG8_SA(1, 0), a3, voffA);
            PG8_BAR; PG8_WAIT_L(0); PG8_MMA(1, 0, At, B0); PG8_BAR; PG8_SCHED;
            PG8_STAGE(PG8_SB(1, 1), b3 + hstepB, voffB);
            PG8_WAIT_V(6); PG8_BAR; PG8_MMA(1, 1, At, B1); PG8_BAR;
            }
        }
        if constexpr (ALIGN_EPI) { if (wr == 0) PG8_BAR; }
        if constexpr (!Epi::AFTER_DRAIN) { if constexpr (Epi::RSTD) E(acc, cur, wr, wc, fr, fq, (const PG8_LAS float*)(lds + STAGE_BYTES), cur.pm == pm0); else E(acc, cur, wr, wc, fr, fq); S.done(cur); }
        if (!has_next) break;
#pragma unroll
        for (int a = 0; a < 2; ++a)
#pragma unroll
            for (int b = 0; b < 2; ++b)
#pragma unroll
                for (int m = 0; m < 4; ++m)
#pragma unroll
                    for (int n = 0; n < 2; ++n) acc[a][b][m][n] = (f32x4){0.f, 0.f, 0.f, 0.f};
        cur = nxt; cA = nA; cB = nB; ++ui;
        if constexpr (ALIGN_EPI) { if (wr == 1) PG8_BAR; }
    }
    PG8_WAIT_V(0);
    if constexpr (!ALIGN_EPI) { if (wr == 0) PG8_BAR; }
    PG8_BAR;
    if constexpr (Epi::AFTER_DRAIN) { E.fused(acc, cur, wr, wc, fr, fq, lds, wid, lane); S.done(cur); }
#undef PG8_ATILE
#undef PG8_SA
#undef PG8_SB
#undef PG8_STAGE
#undef PG8_LDA
#undef PG8_LDB
#undef PG8_MMA
#undef PG8_WAIT_V
#undef PG8_WAIT_L
#undef PG8_WAIT_VK
#undef PG8_BAR
#undef PG8_SCHED
}
}

namespace att {
using bf16x8 = __attribute__((ext_vector_type(8))) short;
using s16x4  = __attribute__((ext_vector_type(4))) short;
using f32x4a = __attribute__((ext_vector_type(4))) float;
using u32x4  = __attribute__((ext_vector_type(4))) unsigned;
using f32x4v = __attribute__((ext_vector_type(4))) float;
#define LASP __attribute__((address_space(3)))
typedef unsigned short bf16_t;
constexpr int NW = 8, QBLK = 32, KVBLK = 64, SEQ = 8192, PITCH = 1024, NT = SEQ / KVBLK;
constexpr int SHM_V = KVBLK * 128 * 2, SHM_K = KVBLK * 64 * 2, NSTG = 6, STGB = SHM_K + SHM_V;
#define SBAR() __builtin_amdgcn_sched_barrier(0)
#define MM16(A_, B_, C_) __builtin_amdgcn_mfma_f32_16x16x32_bf16(A_, B_, C_, 0, 0, 0)
__device__ __forceinline__ unsigned cvtpk(float lo, float hi) { unsigned r; asm volatile("v_cvt_pk_bf16_f32 %0, %1, %2" : "=v"(r) : "v"(lo), "v"(hi)); return r; }
constexpr int v_rd_off(int db, int s, int hb) { return db * 2048 + s * 1024 + hb * 512; }
template <int OFF> __device__ __forceinline__ s16x4 tr_read(int vb) { s16x4 r; asm volatile("ds_read_b64_tr_b16 %0, %1 offset:%2" : "=&v"(r) : "v"(vb), "i"(OFF) : "memory"); return r; }
struct VSet { s16x4 l0, h0, l1, h1, l2, h2, l3, h3; };
template <int B> __device__ __forceinline__ void vread(VSet& v, int vb) {
  v.l0 = tr_read<v_rd_off(2 * B, 0, 0)>(vb); v.h0 = tr_read<v_rd_off(2 * B, 0, 1)>(vb); v.l1 = tr_read<v_rd_off(2 * B, 1, 0)>(vb); v.h1 = tr_read<v_rd_off(2 * B, 1, 1)>(vb);
  v.l2 = tr_read<v_rd_off(2 * B + 1, 0, 0)>(vb); v.h2 = tr_read<v_rd_off(2 * B + 1, 0, 1)>(vb); v.l3 = tr_read<v_rd_off(2 * B + 1, 1, 0)>(vb); v.h3 = tr_read<v_rd_off(2 * B + 1, 1, 1)>(vb);
}
template <int B> __device__ __forceinline__ void pvmm(f32x4a (&o)[2][8], const VSet& v, const bf16x8 (&pa)[2][2]) {
#define PK(L, H) (bf16x8){L[0], L[1], L[2], L[3], H[0], H[1], H[2], H[3]}
  const bf16x8 v00 = PK(v.l0, v.h0), v01 = PK(v.l1, v.h1), v10 = PK(v.l2, v.h2), v11 = PK(v.l3, v.h3);
  o[0][2 * B] = MM16(pa[0][0], v00, o[0][2 * B]); o[1][2 * B] = MM16(pa[1][0], v00, o[1][2 * B]); o[0][2 * B + 1] = MM16(pa[0][0], v10, o[0][2 * B + 1]); o[1][2 * B + 1] = MM16(pa[1][0], v10, o[1][2 * B + 1]);
  o[0][2 * B] = MM16(pa[0][1], v01, o[0][2 * B]); o[1][2 * B] = MM16(pa[1][1], v01, o[1][2 * B]); o[0][2 * B + 1] = MM16(pa[0][1], v11, o[0][2 * B + 1]); o[1][2 * B + 1] = MM16(pa[1][1], v11, o[1][2 * B + 1]);
#undef PK
}
__device__ __forceinline__ void kload(bf16x8 (&kf)[4][2], const char* Ks, int ko0, int ko1) {
#pragma unroll
  for (int kb = 0; kb < 4; ++kb) { kf[kb][0] = *reinterpret_cast<const bf16x8*>(Ks + ko0 + 2048 * kb); kf[kb][1] = *reinterpret_cast<const bf16x8*>(Ks + ko1 + 2048 * kb); }
}
__device__ __forceinline__ void qkt_r(f32x4a (&s)[4][2], const bf16x8 (&kf)[4][2], const bf16x8 (&qr)[2][2]) {
  const f32x4a z4 = {0.f, 0.f, 0.f, 0.f};
#pragma unroll
  for (int kb = 0; kb < 4; ++kb)
#pragma unroll
    for (int qb = 0; qb < 2; ++qb) s[kb][qb] = MM16(kf[kb][0], qr[qb][0], z4);
#pragma unroll
  for (int kb = 0; kb < 4; ++kb)
#pragma unroll
    for (int qb = 0; qb < 2; ++qb) s[kb][qb] = MM16(kf[kb][1], qr[qb][1], s[kb][qb]);
}
__device__ __forceinline__ void qkt2(f32x4a (&s)[4][2], const char* Ks, int ko0, int ko1, const bf16x8 (&qr)[2][2]) {
  const f32x4a z4 = {0.f, 0.f, 0.f, 0.f};
#pragma unroll
  for (int h2 = 0; h2 < 2; ++h2) { bf16x8 kf[2][2];
#pragma unroll
    for (int k2 = 0; k2 < 2; ++k2) { kf[k2][0] = *reinterpret_cast<const bf16x8*>(Ks + ko0 + 2048 * (2 * h2 + k2)); kf[k2][1] = *reinterpret_cast<const bf16x8*>(Ks + ko1 + 2048 * (2 * h2 + k2)); }
    SBAR();
#pragma unroll
    for (int k2 = 0; k2 < 2; ++k2)
#pragma unroll
      for (int qb = 0; qb < 2; ++qb) s[2 * h2 + k2][qb] = MM16(kf[k2][0], qr[qb][0], z4);
#pragma unroll
    for (int k2 = 0; k2 < 2; ++k2)
#pragma unroll
      for (int qb = 0; qb < 2; ++qb) s[2 * h2 + k2][qb] = MM16(kf[k2][1], qr[qb][1], s[2 * h2 + k2][qb]);
    SBAR(); }
}
#define LWAIT() do { asm volatile("s_waitcnt lgkmcnt(0)" ::: "memory"); SBAR(); } while (0)
__device__ __forceinline__ void finishSM(f32x4a (&s)[4][2], float& l0, float& l1, bf16x8 (&pa)[2][2]) {
#pragma unroll
  for (int kb = 0; kb < 4; ++kb)
#pragma unroll
    for (int qb = 0; qb < 2; ++qb)
#pragma unroll
      for (int e = 0; e < 4; ++e) s[kb][qb][e] = __builtin_amdgcn_exp2f(s[kb][qb][e]);
  float a0 = 0.f, a1 = 0.f, a2 = 0.f, a3 = 0.f, b0 = 0.f, b1 = 0.f, b2 = 0.f, b3 = 0.f;
#pragma unroll
  for (int kb = 0; kb < 4; ++kb) { a0 += s[kb][0][0]; a1 += s[kb][0][1]; a2 += s[kb][0][2]; a3 += s[kb][0][3]; b0 += s[kb][1][0]; b1 += s[kb][1][1]; b2 += s[kb][1][2]; b3 += s[kb][1][3]; }
  l0 += (a0 + a1) + (a2 + a3); l1 += (b0 + b1) + (b2 + b3);
#pragma unroll
  for (int qb = 0; qb < 2; ++qb)
#pragma unroll
    for (int st = 0; st < 2; ++st) { u32x4 w = {cvtpk(s[2 * st][qb][0], s[2 * st][qb][1]), cvtpk(s[2 * st][qb][2], s[2 * st][qb][3]), cvtpk(s[2 * st + 1][qb][0], s[2 * st + 1][qb][1]), cvtpk(s[2 * st + 1][qb][2], s[2 * st + 1][qb][3])};
      pa[qb][st] = *reinterpret_cast<bf16x8*>(&w); }
}

struct Tensors { const bf16_t* Q; const bf16_t* K; const bf16_t* V; bf16_t* YA; float* O0; const float* gsub; int lam_bits; int li_bits; };
constexpr int STG_LD = 132, STG_BYTES = 32 * STG_LD * 4;
constexpr int LDS_WS = NSTG * STGB > NW * STG_BYTES ? NSTG * STGB : NW * STG_BYTES, LDS_BYTES = LDS_WS + NW * 64 * 4;
__device__ __forceinline__ void attn_unit(int h, int qb_, const Tensors& T, char* lds, LASP unsigned char* ldsl, int tid_in) {
  int tid_ = tid_in; asm volatile("" : "+v"(tid_));
  const int tid = tid_, lane = tid & 63, c16 = lane & 15, g = lane >> 4; const int wid = __builtin_amdgcn_readfirstlane(tid >> 6);
  float* wsf = (float*)(lds + LDS_WS) + wid * 64; float* stg = (float*)(lds + wid * STG_BYTES);
  const int q0 = qb_ * (QBLK * NW);
  unsigned dK, dV0, dV1;
  { const int key = 8 * wid + (lane >> 3), ch = (lane & 7) ^ ((key >> 1) & 7); dK = (unsigned)((key * PITCH + ch * 8) * 2);
    { const int u = 64 * (2 * wid) + lane; dV0 = (unsigned)((((u >> 1) & 63) * PITCH + 16 * (u >> 7) + 8 * (u & 1)) * 2); }
    { const int u = 64 * (2 * wid + 1) + lane; dV1 = (unsigned)((((u >> 1) & 63) * PITCH + 16 * (u >> 7) + 8 * (u & 1)) * 2); } }
  const int vb0 = (int)(uintptr_t)lds + SHM_K + 128 * g + 32 * (c16 >> 2) + 8 * (c16 & 3);
  const int kx = (c16 >> 1) & 7, ko0 = c16 * 128 + ((g ^ kx) << 4), ko1 = c16 * 128 + (((4 + g) ^ kx) << 4);
  const size_t TILE_B = (size_t)KVBLK * PITCH * 2;
  unsigned op[2][8][2];
#pragma unroll
  for (int qb = 0; qb < 2; ++qb)
#pragma unroll
    for (int db = 0; db < 8; ++db) { op[qb][db][0] = 0u; op[qb][db][1] = 0u; }
  {
    const char* Kt = (const char*)(T.K + h * 128); const char* Vt = (const char*)(T.V + h * 128);
    const char* Qw = (const char*)T.Q + (size_t)(unsigned)(((q0 + wid * QBLK + c16) * PITCH + h * 128 + g * 8) * 2);
    bf16x8 qr[2][2];
#pragma unroll
    for (int qb = 0; qb < 2; ++qb)
#pragma unroll
      for (int ks = 0; ks < 2; ++ks) qr[qb][ks] = *reinterpret_cast<const bf16x8*>(Qw + qb * (16 * PITCH * 2) + ks * 64);
    float l0 = 0.f, l1 = 0.f; f32x4a o[2][8];
#pragma unroll
    for (int qb = 0; qb < 2; ++qb)
#pragma unroll
      for (int db = 0; db < 8; ++db) o[qb][db] = (f32x4a){0.f, 0.f, 0.f, 0.f};
#define ABAR() asm volatile("s_waitcnt lgkmcnt(0)\n\ts_barrier" ::: "memory")
#define DMA_TILE(tt, sg_) do { const int tc_ = (tt) < 2 * NT ? (tt) : 2 * NT - 1; const char* kb_ = Kt + (size_t)(tc_ & (NT - 1)) * TILE_B + (tc_ >> 7) * 128; const char* vb_ = Vt + (size_t)(tc_ & (NT - 1)) * TILE_B; asm volatile("" : "+s"(kb_), "+s"(vb_)); \
      LASP unsigned char* sb_ = ldsl + (sg_) * STGB; \
      __builtin_amdgcn_global_load_lds((const unsigned*)(kb_ + dK), (LASP unsigned*)(sb_ + wid * 1024), 16, 0, 0); \
      __builtin_amdgcn_global_load_lds((const unsigned*)(vb_ + dV0), (LASP unsigned*)(sb_ + SHM_K + (2 * wid) * 1024), 16, 0, 0); \
      __builtin_amdgcn_global_load_lds((const unsigned*)(vb_ + dV1), (LASP unsigned*)(sb_ + SHM_K + (2 * wid + 1) * 1024), 16, 0, 0); } while (0)
    const int hf = wid >> 2; constexpr int dist = 4;
    f32x4a s[4][2]; bf16x8 pa[2][2];
    DMA_TILE(0, 0); DMA_TILE(1, 1); DMA_TILE(2, 2); DMA_TILE(3, 3);
    asm volatile("s_waitcnt vmcnt(6)" ::: "memory");
    __syncthreads();
    VSet va, vb_;
    if (hf) ABAR();
    qkt2(s, lds, ko0, ko1, qr);
    if (!hf) ABAR();
    int sgv = 0, sgd = dist;
#pragma unroll 1
    for (int t = 0; t < 2 * NT; ++t) {
      DMA_TILE(t + dist, sgd); sgd = sgd == NSTG - 1 ? 0 : sgd + 1;
      if (t == NT - 1) {
#pragma unroll
        for (int qb = 0; qb < 2; ++qb)
#pragma unroll
          for (int ks = 0; ks < 2; ++ks) qr[qb][ks] = *reinterpret_cast<const bf16x8*>(Qw + 128 + qb * (16 * PITCH * 2) + ks * 64); }
      SBAR();
      finishSM(s, l0, l1, pa);
      if (hf) { asm volatile("s_waitcnt vmcnt(6)" ::: "memory"); ABAR(); }
      { const int vbt = vb0 + sgv * STGB; const int sgk = sgv == NSTG - 1 ? 0 : sgv + 1; __builtin_amdgcn_s_setprio(1);
        vread<0>(va, vbt); SBAR();
        if (t + 1 < 2 * NT) qkt2(s, lds + sgk * STGB, ko0, ko1, qr);
        LWAIT(); vread<1>(vb_, vbt); SBAR(); pvmm<0>(o, va, pa); SBAR();
        LWAIT(); vread<2>(va, vbt); SBAR(); pvmm<1>(o, vb_, pa); SBAR();
        LWAIT(); vread<3>(vb_, vbt); SBAR(); pvmm<2>(o, va, pa); SBAR();
        LWAIT(); pvmm<3>(o, vb_, pa); SBAR();
        __builtin_amdgcn_s_setprio(0);
        sgv = sgk; }
      if (t == NT - 1) {
        l0 = pg8::sum_fq(l0); l1 = pg8::sum_fq(l1);
        int ln; asm volatile("v_mbcnt_lo_u32_b32 %0, -1, 0\n\tv_mbcnt_hi_u32_b32 %0, -1, %0" : "=v"(ln));
        if ((ln >> 4) == 0) { wsf[ln & 15] = l0; wsf[16 + (ln & 15)] = l1; }
        asm volatile("s_waitcnt lgkmcnt(0)" ::: "memory");
#pragma unroll
        for (int qb = 0; qb < 2; ++qb) { const f32x4v lv = *(const f32x4v*)(wsf + 16 * qb + 4 * (ln >> 4));
          const float r0 = __builtin_amdgcn_rcpf(lv[0]), r1 = __builtin_amdgcn_rcpf(lv[1]), r2 = __builtin_amdgcn_rcpf(lv[2]), r3 = __builtin_amdgcn_rcpf(lv[3]);
#pragma unroll
          for (int db = 0; db < 8; ++db) { op[qb][db][0] = cvtpk(o[qb][db][0] * r0, o[qb][db][1] * r1); op[qb][db][1] = cvtpk(o[qb][db][2] * r2, o[qb][db][3] * r3); o[qb][db] = (f32x4a){0.f, 0.f, 0.f, 0.f}; } }
        asm volatile("s_waitcnt lgkmcnt(0)" ::: "memory");
        l0 = 0.f; l1 = 0.f; }
      if (!hf) { asm volatile("s_waitcnt vmcnt(6)" ::: "memory"); ABAR(); }
    }
    asm volatile("s_waitcnt vmcnt(0)" ::: "memory");
#undef ABAR
#undef DMA_TILE
    l0 = pg8::sum_fq(l0); l1 = pg8::sum_fq(l1);
    int lane2; asm volatile("v_mbcnt_lo_u32_b32 %0, -1, 0\n\tv_mbcnt_hi_u32_b32 %0, -1, %0" : "=v"(lane2));
    const int c16e = lane2 & 15, ge = lane2 >> 4;
    if (ge == 0) { wsf[c16e] = l0; wsf[16 + c16e] = l1; }
    asm volatile("s_waitcnt lgkmcnt(0)" ::: "memory");
    {
      __syncthreads();
      int lb_ = T.lam_bits, ib_ = T.li_bits; asm volatile("" : "+s"(lb_), "+s"(ib_));
      const float lam = __builtin_bit_cast(float, lb_), osc = 1.0f - __builtin_bit_cast(float, ib_);
      const int lr = lane2 >> 3, ch = lane2 & 7;
      f32x4v gs[4];
#pragma unroll
      for (int i = 0; i < 4; ++i) gs[i] = *(const f32x4v*)(T.gsub + 16 * ch + 4 * i);
      { float* sw = stg + (4 * ge) * STG_LD + c16e;
#pragma unroll
        for (int qb = 0; qb < 2; ++qb) { const f32x4v lv = *(const f32x4v*)(wsf + 16 * qb + 4 * ge);
#pragma unroll
          for (int e = 0; e < 4; ++e) { const float rl = __builtin_amdgcn_rcpf(lv[e]) * lam;
#pragma unroll
            for (int db = 0; db < 8; ++db) { const unsigned w = op[qb][db][e >> 1]; const float o0 = __builtin_bit_cast(float, (e & 1) ? (w & 0xffff0000u) : (w << 16));
              sw[(16 * qb + e) * STG_LD + 16 * db] = o0 - o[qb][db][e] * rl; } } } }
      asm volatile("s_waitcnt lgkmcnt(0)" ::: "memory");
#pragma unroll
      for (int i = 0; i < 4; ++i) gs[i] = gs[i] * osc;
#pragma unroll
      for (int j = 0; j < 4; ++j) { const int row = 8 * j + lr; const float* sp = stg + row * STG_LD + 16 * ch;
        f32x4v a[4]; float ss = 0.f;
#pragma unroll
        for (int i = 0; i < 4; ++i) { a[i] = *(const f32x4v*)(sp + 4 * i); ss += (a[i][0] * a[i][0] + a[i][1] * a[i][1]) + (a[i][2] * a[i][2] + a[i][3] * a[i][3]); }
        ss = pg8::sum8(ss);
        const float rn = 1.0f / sqrtf(ss * (1.0f / 128.0f) + 1e-5f);
        u32x4 w0, w1;
        { const f32x4v y0 = a[0] * rn * gs[0], y1 = a[1] * rn * gs[1], y2 = a[2] * rn * gs[2], y3 = a[3] * rn * gs[3];
          w0 = (u32x4){cvtpk(y0[0], y0[1]), cvtpk(y0[2], y0[3]), cvtpk(y1[0], y1[1]), cvtpk(y1[2], y1[3])}; w1 = (u32x4){cvtpk(y2[0], y2[1]), cvtpk(y2[2], y2[3]), cvtpk(y3[0], y3[1]), cvtpk(y3[2], y3[3])}; }
        char* yp = (char*)T.YA + (size_t)(unsigned)(((q0 + wid * QBLK + row) * 2048 + 1024 + h * 128 + 16 * ch) * 2);
        *(u32x4*)yp = w0; *(u32x4*)(yp + 16) = w1; }
      asm volatile("s_waitcnt vmcnt(0) lgkmcnt(0)" ::: "memory");
      __syncthreads();
    }
  }
}

#undef LWAIT
#undef SBAR
}

constexpr int NWAVES = 8;
constexpr int GEMM_WGM = 4;
constexpr int SEQ = 8192, DM = 2048, DFF = 5632, DEPTH = 4, INW = 4096;
constexpr size_t MiB = 1u << 20;
constexpr size_t WS_CTL = 0, CTL_ZERO_BYTES = 1 * MiB;
constexpr size_t WS_COS = 1 * MiB, WS_SIN = 2 * MiB, WS_SSQ = 3 * MiB;
constexpr size_t WS_A1 = 4 * MiB, WS_A2 = WS_A1 + 65536, WS_TWC = WS_A2 + 65536, WS_TWS = WS_TWC + 32768, WS_LAM = WS_TWS + 32768;
constexpr size_t WS_DT = 5 * MiB;
constexpr size_t WS_XB = 16 * MiB;
constexpr size_t WS_H = 48 * MiB;
constexpr size_t WS_UF = 136 * MiB, WS_UT = 152 * MiB;
constexpr size_t WS_O1T = 168 * MiB;
constexpr size_t WS_YA = 200 * MiB;
constexpr size_t WS_Q = 248 * MiB, WS_K = 264 * MiB, WS_V = 280 * MiB;
constexpr size_t WS_O0 = 296 * MiB;
constexpr size_t WS_WGU = 328 * MiB, SZ_WGU = 44 * MiB;
constexpr size_t WS_WDN = 680 * MiB, SZ_WDN = 22 * MiB;
constexpr size_t WS_WIN = 856 * MiB, SZ_WIN = 16 * MiB;
constexpr size_t WS_WOUT = 920 * MiB, SZ_WOUT = 8 * MiB;
constexpr size_t WS_END = 952 * MiB;
constexpr int CW_BAR = 4096;
constexpr int RING_OFF = 0, RING_BYTES = 151552, LDSCTL_OFF = RING_BYTES, MISC_OFF = LDSCTL_OFF + 320, LDS_BYTES = 155648;
static_assert(att::LDS_BYTES <= RING_BYTES && pg8::STAGE_BYTES <= RING_BYTES && MISC_OFF + 128 <= LDS_BYTES, "LDS map");

#define GAS __attribute__((address_space(1)))
#define LAS __attribute__((address_space(3)))
typedef unsigned short bf16;
typedef unsigned v4u __attribute__((ext_vector_type(4)));
typedef float f32x4 __attribute__((ext_vector_type(4)));
#define LDS_WAIT() asm volatile("s_waitcnt lgkmcnt(0)" ::: "memory")
__device__ __forceinline__ unsigned f2bf(float f) { unsigned u = __builtin_bit_cast(unsigned, f); return (u + 0x7fffu + ((u >> 16) & 1u)) >> 16; }
__device__ __forceinline__ unsigned pk2(float lo, float hi) { return f2bf(lo) | (f2bf(hi) << 16); }

#define XB_TMO      128
#define XB_XCNT(j)  (256  + 64 * (j))
#define XB_XSUB(j)  (1280 + 64 * (j))
#define XB_XGEN(j)  (2304 + 64 * (j))
#define XB_TOP      3328
#define XB_TOPGEN   3392
#define XCD_BAR_WORDS 3456
#define XB_SPIN_CAP (1u << 18)

__device__ __forceinline__ unsigned xb_ld(unsigned* p)              { return __hip_atomic_load(p, __ATOMIC_RELAXED, __HIP_MEMORY_SCOPE_AGENT); }
__device__ __forceinline__ unsigned xb_add(unsigned* p, unsigned v) { return __hip_atomic_fetch_add(p, v, __ATOMIC_RELAXED, __HIP_MEMORY_SCOPE_AGENT); }
__device__ __forceinline__ unsigned xb_xcc_id() { return (unsigned)__builtin_amdgcn_s_getreg((3 << 11) | 20) & 0xFu; }
#define XB_SPIN(cond, bar) do { unsigned _sp = 0; while (cond) { __builtin_amdgcn_s_sleep(1); \
    if ((++_sp & 255u) == 0u) { if (xb_ld(&(bar)[XB_TMO])) break; if (_sp > XB_SPIN_CAP) { atomicAdd(&(bar)[XB_TMO], 1u); break; } } } } while (0)

struct XcdBarrier {
    unsigned* bar; unsigned x;
    volatile LAS unsigned* st;
};

__device__ __forceinline__ XcdBarrier xcd_barrier_post(unsigned* bar, volatile LAS unsigned* st, bool leader) {
    XcdBarrier b; b.bar = bar; b.x = xb_xcc_id(); b.st = st;
    if (leader) (void)xb_add(&bar[XB_XCNT(b.x)], 1u);
    return b;
}
__device__ __forceinline__ void xcd_barrier_complete(unsigned* bar, unsigned x, unsigned& nloc, unsigned& nx) {
    const unsigned G = gridDim.x * gridDim.y * gridDim.z;
    unsigned sum, cnt, mine, sp = 0u;
    for (;;) {
        sum = 0u; cnt = 0u; mine = 0u;
#pragma unroll
        for (unsigned j = 0; j < 16; ++j) { const unsigned c = xb_ld(&bar[XB_XCNT(j)]); sum += c; cnt += (c > 0u) ? 1u : 0u; mine = (j == x) ? c : mine; }
        if (sum == G) break;
        __builtin_amdgcn_s_sleep(1);
        if ((++sp & 255u) == 0u) { if (xb_ld(&bar[XB_TMO])) break; if (sp > XB_SPIN_CAP) { atomicAdd(&bar[XB_TMO], 1u); break; } }
    }
    nloc = mine > 0u ? mine : 1u; nx = cnt > 0u ? cnt : 1u;
}

__device__ __forceinline__ void xcd_barrier(const XcdBarrier& b, bool leader) {
    asm volatile("s_waitcnt vmcnt(0)" ::: "memory");
    __syncthreads();
    if (leader) {
        unsigned* bar = b.bar;
        __builtin_amdgcn_s_waitcnt(0);
        unsigned nloc = b.st[0], nx = b.st[1];
        if (nloc == 0u) { xcd_barrier_complete(bar, b.x, nloc, nx); b.st[0] = nloc; b.st[1] = nx; }
        const unsigned old = xb_add(&bar[XB_XSUB(b.x)], 1u);
        const unsigned gen = old / nloc;
        if (old + 1u == (gen + 1u) * nloc) {
            __builtin_amdgcn_fence(__ATOMIC_RELEASE, "agent");
            asm volatile("s_waitcnt vmcnt(0)" ::: "memory");
            const unsigned og = xb_add(&bar[XB_TOP], 1u);
            const unsigned tg = og / nx;
            if (og + 1u == (tg + 1u) * nx) xb_add(&bar[XB_TOPGEN], 1u);
            else XB_SPIN(xb_ld(&bar[XB_TOPGEN]) == tg, bar);
            __builtin_amdgcn_fence(__ATOMIC_ACQUIRE, "agent");
            xb_add(&bar[XB_XGEN(b.x)], 1u);
            asm volatile("s_waitcnt vmcnt(0)" ::: "memory");
        } else {
            XB_SPIN(xb_ld(&bar[XB_XGEN(b.x)]) == gen, bar);
            __builtin_amdgcn_fence(__ATOMIC_ACQUIRE, "agent");
            asm volatile("s_waitcnt vmcnt(0)" ::: "memory");
        }
    }
    __syncthreads();
}

__device__ __forceinline__ float wave_sum(float v) {
    v = pg8::sum8(v); v += pg8::dpp_f<0x140>(v);
    return pg8::sum_xor32(pg8::sum_xor16(v));
}
struct Args { const float* in[20]; float* out; unsigned char* ws; float lam_init[4]; };
typedef const Args __attribute__((address_space(4))) * KArgP;
struct Item { const float* src; const float* gain; bf16* dst; int ldsrc, scol0, k0, ldd, drow, dk0; };
__device__ __forceinline__ void tr_load(const Item& I, f32x4 (&v)[8], int lane) {
    const int lr = lane >> 3, lc = lane & 7;
#pragma unroll
    for (int i = 0; i < 8; ++i) v[i] = __builtin_nontemporal_load((const GAS f32x4*)(I.src + (size_t)(I.k0 + i * 8 + lr) * I.ldsrc + I.scol0 + 4 * lc));
}
__device__ __forceinline__ void tr_finish(const Item& I, const f32x4 (&v)[8], LAS float* scr, int lane) {
    const int lr = lane >> 3, lc = lane & 7;
    f32x4 g0 = (f32x4){1.f, 1.f, 1.f, 1.f}, g1 = g0;
    if (I.gain) { g0 = *(const GAS f32x4*)(I.gain + I.k0 + 8 * lc); g1 = *(const GAS f32x4*)(I.gain + I.k0 + 8 * lc + 4); }
#pragma unroll
    for (int i = 0; i < 8; ++i) { LAS float* s = scr + (i * 8 + lr) * 33 + 4 * lc; s[0] = v[i][0]; s[1] = v[i][1]; s[2] = v[i][2]; s[3] = v[i][3]; }
    LDS_WAIT(); asm volatile("" ::: "memory");
#pragma unroll
    for (int j = 0; j < 4; ++j) { const int n = lr + 8 * j; const LAS float* s = scr + (8 * lc) * 33 + n;
        v4u o; o.x = pg8::cvt_pk_bf16(s[0 * 33] * g0[0], s[1 * 33] * g0[1]); o.y = pg8::cvt_pk_bf16(s[2 * 33] * g0[2], s[3 * 33] * g0[3]); o.z = pg8::cvt_pk_bf16(s[4 * 33] * g1[0], s[5 * 33] * g1[1]); o.w = pg8::cvt_pk_bf16(s[6 * 33] * g1[2], s[7 * 33] * g1[3]);
        *(GAS v4u*)(I.dst + (size_t)(I.drow + n) * I.ldd + I.dk0 + 8 * lc) = o; }
    LDS_WAIT(); asm volatile("" ::: "memory");
}
constexpr int I_GU = 32 * 352, I_DN = 88 * 64, I_WIN = 32 * 128, I_WO = 32 * 64, I_L = 2 * I_GU + 2 * I_DN + I_WIN + I_WO;
__device__ __forceinline__ Item decode_item(KArgP argp, unsigned char* ws, int l, int it) {
    Item I; int r = it;
    if (r < 2 * I_GU) { const int f = r >= I_GU; r -= f * I_GU; const int kb = r / 352, nb = r - kb * 352, n0 = 32 * nb, t = n0 >> 8, s = (n0 >> 7) & 1, j0 = n0 & 127;
        I.src = argp->in[f ? (s ? 18 : 17) : (s ? 4 : 3)] + (size_t)l * DM * DFF; I.ldsrc = DFF; I.scol0 = 128 * t + j0; I.k0 = 64 * kb; I.gain = argp->in[f ? 16 : 2] + l * DM;
        I.dst = (bf16*)(ws + WS_WGU + (size_t)(l * 2 + f) * SZ_WGU); I.ldd = DM; I.drow = n0; I.dk0 = 64 * kb; return I; }
    r -= 2 * I_GU;
    if (r < 2 * I_DN) { const int f = r >= I_DN; r -= f * I_DN; const int kb = r >> 6, nb = r & 63;
        I.src = argp->in[f ? 19 : 5] + (size_t)l * DFF * DM; I.ldsrc = DM; I.scol0 = 32 * nb; I.k0 = 64 * kb; I.gain = nullptr;
        I.dst = (bf16*)(ws + WS_WDN + (size_t)(l * 2 + f) * SZ_WDN); I.ldd = DFF; I.drow = 32 * nb; I.dk0 = 64 * kb; return I; }
    r -= 2 * I_DN;
    if (r < I_WIN) { const int kb = r >> 7, nb = r & 127, n0 = 32 * nb, pn = n0 >> 8; int scol0 = n0;
        if (pn >= 4 && pn < 12) { const int tcol = n0 & 255, bj = tcol >> 7, wc = (tcol >> 5) & 3, vec = 4 * (pn & 3) + wc; scol0 = (pn < 8 ? 1024 : 2048) + vec * 64 + 32 * bj; }
        I.src = argp->in[7] + (size_t)l * DM * INW; I.ldsrc = INW; I.scol0 = scol0; I.k0 = 64 * kb; I.gain = argp->in[6] + l * DM;
        I.dst = (bf16*)(ws + WS_WIN + (size_t)l * SZ_WIN); I.ldd = DM; I.drow = n0; I.dk0 = 64 * kb; return I; }
    r -= I_WIN;
    { const int kb = r >> 6, nb = r & 63; I.src = argp->in[15] + (size_t)l * DM * DM; I.ldsrc = DM; I.scol0 = 32 * nb; I.k0 = 64 * kb; I.gain = nullptr; I.drow = 32 * nb;
      I.dst = (bf16*)(ws + WS_WOUT + (size_t)l * SZ_WOUT); I.ldd = DM; I.dk0 = 64 * kb; }
    return I;
}
__device__ __forceinline__ Item decode_global(KArgP argp, unsigned char* ws, int g) { const int q = g / I_L; return decode_item(argp, ws, DEPTH - 1 - q, g - q * I_L); }
__device__ __forceinline__ void p0_prologue(KArgP argp, LAS unsigned char* lds, int vcu, int G, int wave, int lane) {
    unsigned char* ws = argp->ws;
    LAS float* scr = (LAS float*)(lds + RING_OFF + wave * 16384);
    const int gw = vcu * NWAVES + wave, NGW = G * NWAVES;
    { int it = gw;
      if (it < DEPTH * I_L) { Item a = decode_global(argp, ws, it), b = a; f32x4 va[8], vb[8];
        tr_load(a, va, lane);
        for (;;) {
            it += NGW; const bool m1 = it < DEPTH * I_L; if (m1) { b = decode_global(argp, ws, it); tr_load(b, vb, lane); }
            tr_finish(a, va, scr, lane); if (!m1) break;
            it += NGW; const bool m2 = it < DEPTH * I_L; if (m2) { a = decode_global(argp, ws, it); tr_load(a, va, lane); }
            tr_finish(b, vb, scr, lane); if (!m2) break;
        } } }
    { const float* x = argp->in[0]; bf16* xb = (bf16*)(ws + WS_XB); float* ssq = (float*)(ws + WS_SSQ);
      for (int m = gw; m < SEQ; m += NGW) { const GAS f32x4* xr = (const GAS f32x4*)(x + (size_t)m * DM) + lane; f32x4 v[8]; float s = 0.f;
#pragma unroll
          for (int j = 0; j < 8; ++j) { v[j] = xr[64 * j]; s += (v[j][0] * v[j][0] + v[j][1] * v[j][1]) + (v[j][2] * v[j][2] + v[j][3] * v[j][3]); }
          s = wave_sum(s);
          GAS unsigned long long* o8 = (GAS unsigned long long*)(xb + (size_t)m * DM) + lane;
#pragma unroll
          for (int j = 0; j < 8; ++j) o8[64 * j] = (unsigned long long)pk2(v[j][0], v[j][1]) | ((unsigned long long)pk2(v[j][2], v[j][3]) << 32);
          if (lane < 32) ssq[(size_t)m * 32 + lane] = lane == 0 ? s : 0.f; } }
    const int gt = gw * 64 + lane, NGT = NGW * 64;
    { const int* pos = (const int*)argp->in[1]; float* cosT = (float*)(ws + WS_COS); float* sinT = (float*)(ws + WS_SIN);
      for (int e = gt; e < SEQ * 32; e += NGT) { const int t = e >> 5, i = e & 31; double f = 1.0; for (int k = 0; k < i; ++k) f *= 0.7498942093324559;
          double rev = (double)pos[t] * f * 0.15915494309189535; rev -= __builtin_floor(rev); const float fr = (float)rev;
          cosT[e] = __builtin_amdgcn_cosf(fr); sinT[e] = __builtin_amdgcn_sinf(fr); } }
    { bf16* A1 = (bf16*)(ws + WS_A1); bf16* A2 = (bf16*)(ws + WS_A2);
      for (int e = gt; e < 256 * 128; e += NGT) { const int r = e >> 7, cc = e & 127;
          { const int p = r >> 7, k1 = r & 127; const float ph = (float)((k1 * cc) & 127) * (1.0f / 128.0f);
            A1[e] = (bf16)f2bf((p == 0 ? __builtin_amdgcn_cosf(ph) : -__builtin_amdgcn_sinf(ph)) * 0.0625f); }
          { float val = 0.f; if (r < 128) { const int pp = r >> 6, k2 = r & 63, p = cc >> 6, s2 = cc & 63; const float ph = (float)((k2 * s2) & 63) * (1.0f / 64.0f);
                const float c = __builtin_amdgcn_cosf(ph), s = __builtin_amdgcn_sinf(ph); val = (pp == p) ? c : (pp == 0 ? s : -s); }
            A2[e] = (bf16)f2bf(val * 0.125f); } } }
    { float* TWC = (float*)(ws + WS_TWC); float* TWS = (float*)(ws + WS_TWS);
      for (int e = gt; e < 128 * 64; e += NGT) { const int k1 = e >> 6, s2 = e & 63; const float ph = (float)(k1 * s2) * (1.0f / 8192.0f); TWC[e] = __builtin_amdgcn_cosf(ph); TWS[e] = __builtin_amdgcn_sinf(ph); } }
    { bf16* DTm = (bf16*)(ws + WS_DT);
      for (int e = gt; e < 128 * 256; e += NGT) { const int c2 = e >> 8, pp = (e >> 7) & 1, c = e & 127; const float ph = (float)((c * c2) & 127) * (1.0f / 128.0f);
          DTm[e] = (bf16)f2bf((pp ? __builtin_amdgcn_sinf(ph) : __builtin_amdgcn_cosf(ph)) * 0.125f); } }
    if (gw < DEPTH) { const int l = gw; float* lam = (float*)(ws + WS_LAM);
        const float a = wave_sum(argp->in[10][l * 64 + lane] * argp->in[11][l * 64 + lane]), b = wave_sum(argp->in[12][l * 64 + lane] * argp->in[13][l * 64 + lane]);
        if (lane == 0) lam[l] = __builtin_amdgcn_exp2f(a * 1.4426950408889634f) - __builtin_amdgcn_exp2f(b * 1.4426950408889634f) + argp->lam_init[l]; }
}

__device__ __forceinline__ int lane_id_fresh() { int l; asm volatile("v_mbcnt_lo_u32_b32 %0, -1, 0\n\tv_mbcnt_hi_u32_b32 %0, -1, %0" : "=v"(l)); return l; }
#define KARGS() KArgP ap = (KArgP)__builtin_amdgcn_kernarg_segment_ptr(); asm volatile("" : "+s"(ap)); unsigned char* const ws = ap->ws; (void)ws
#define GRID_BAR() do { KArgP ap_ = (KArgP)__builtin_amdgcn_kernarg_segment_ptr(); asm volatile("" : "+s"(ap_)); XcdBarrier b_; b_.bar = (unsigned*)(ap_->ws + WS_CTL) + CW_BAR; b_.x = xb_xcc_id(); \
    b_.st = (volatile LAS unsigned*)(lds + MISC_OFF) + 8; xcd_barrier(b_, MYTID() == 0); } while (0)
typedef pg8::bf16_t pb;
__global__ void __launch_bounds__(NWAVES * 64, 2) enc_fwd(Args args_unused) {
    extern __shared__ __attribute__((aligned(16))) unsigned char lds_raw[];
    LAS unsigned char* lds = (LAS unsigned char*)lds_raw;
    const int wave_s = __builtin_amdgcn_readfirstlane((int)threadIdx.x >> 6);
#define MYTID() ((wave_s << 6) | lane_id_fresh())
    const int G = gridDim.x; const int bx = blockIdx.x; const int vcu = (G % 8 == 0) ? (bx % 8) * (G / 8) + bx / 8 : bx;
    for (int u = threadIdx.x; u < (LDS_BYTES - LDSCTL_OFF) / 4; u += NWAVES * 64) ((LAS unsigned*)(lds + LDSCTL_OFF))[u] = 0u;
    __syncthreads();
    { KARGS(); (void)xcd_barrier_post((unsigned*)(ws + WS_CTL) + CW_BAR, (volatile LAS unsigned*)(lds + MISC_OFF) + 8, MYTID() == 0); }

    { KARGS(); const int tid = MYTID(); p0_prologue(ap, lds, vcu, G, wave_s, tid & 63); }
    GRID_BAR();

    for (int l = 0; l < DEPTH; ++l) {
        for (int f = 0; f < 2; ++f) {
            { KARGS(); pg8::Gemm g{(const pb*)(ws + WS_XB), (const pb*)(ws + WS_WGU + (size_t)(l * 2 + f) * SZ_WGU), SEQ, 2 * DFF, DM, DM, DM}; pg8::StaticOrder S; S.init(g.M, g.N, G, bx, GEMM_WGM); S.nlim = (S.nwg / G) * G;
              pg8::EpiSwiGLU<false> E{(pb*)(ws + WS_H), (const float*)(ws + WS_SSQ)};
              pg8::gemm_phase<pg8::EpiSwiGLU<false>, pg8::StaticOrder, true, true>(lds + RING_OFF, g, S, E, MYTID()); }
            { KARGS(); pg8::Gemm g{(const pb*)(ws + WS_XB), (const pb*)(ws + WS_WGU + (size_t)(l * 2 + f) * SZ_WGU), SEQ, 2 * DFF, DM, DM, DM}; pg8::TailHalves S; S.S.init(g.M, g.N, G, bx, GEMM_WGM); S.first = (S.S.nwg / G) * G;
              pg8::EpiSwiGLU<true> E{(pb*)(ws + WS_H), (const float*)(ws + WS_SSQ)};
              pg8::gemm_phase<pg8::EpiSwiGLU<true>, pg8::TailHalves, true, true, true>(lds + RING_OFF, g, S, E, MYTID()); }
            GRID_BAR();
            { KARGS(); pg8::Gemm g{(const pb*)(ws + WS_H), (const pb*)(ws + WS_WDN + (size_t)(l * 2 + f) * SZ_WDN), SEQ, DM, DFF, DFF, DFF}; pg8::StaticOrder S; S.init(g.M, g.N, G, bx, GEMM_WGM);
              const int wf_ = __builtin_amdgcn_readfirstlane((l == DEPTH - 1 && f == 1) ? 1 : 0); pg8::EpiResid E{(pb*)(ws + WS_XB), (float*)(ws + WS_SSQ), ap->out, 0.5f, wf_};
              pg8::gemm_phase<pg8::EpiResid, pg8::StaticOrder, true, true>(lds + RING_OFF, g, S, E, MYTID()); }
            if (l == DEPTH - 1 && f == 1) break;
            GRID_BAR();
            if (f == 0) {
                { KARGS(); pg8::Gemm g{(const pb*)(ws + WS_XB), (const pb*)(ws + WS_WIN + (size_t)l * SZ_WIN), SEQ, INW, DM, DM, DM}; pg8::StaticOrder S; S.init(g.M, g.N, G, bx, GEMM_WGM);
                  pg8::EpiWin E{(const float*)(ws + WS_SSQ), (pb*)(ws + WS_UT), (pb*)(ws + WS_Q), (pb*)(ws + WS_K), (pb*)(ws + WS_V), (const float*)(ws + WS_COS), (const float*)(ws + WS_SIN), ap->in[8] + l * 64, ap->in[9] + l * 64};
                  pg8::gemm_phase<pg8::EpiWin, pg8::StaticOrder, true, true, false, true>(lds + RING_OFF, g, S, E, MYTID()); }
                GRID_BAR();
                {
                { KARGS(); pg8::Gemm g{(const pb*)(ws + WS_A1), (const pb*)(ws + WS_UT), 256, 65536, 128, 128, 128}; pg8::StaticOrder S; S.init(g.M, g.N, G, bx, GEMM_WGM);
                  pg8::EpiFft1 E{(pb*)(ws + WS_O1T), (const float*)(ws + WS_TWC), (const float*)(ws + WS_TWS)};
                  pg8::gemm_phase<pg8::EpiFft1, pg8::StaticOrder, true, true>(lds + RING_OFF, g, S, E, MYTID()); }
                GRID_BAR();
#pragma unroll 1
                for (int r = 0; r * G < 512; ++r) { KARGS(); pg8::Gemm g{(const pb*)(ws + WS_A2), (const pb*)(ws + WS_O1T), 256, 131072, 128, 128, 128}; pg8::OneRound S; S.S.init(g.M, g.N, G, bx, GEMM_WGM); S.r = r;
                  pg8::EpiFft2 E{(pb*)(ws + WS_YA), (const pb*)(ws + WS_DT)};
                  pg8::gemm_phase<pg8::EpiFft2, pg8::OneRound, true, true>(lds + RING_OFF, g, S, E, MYTID()); }
                }
                { KARGS(); att::Tensors T{(const pb*)(ws + WS_Q), (const pb*)(ws + WS_K), (const pb*)(ws + WS_V), (pb*)(ws + WS_YA), (float*)(ws + WS_O0), ap->in[14] + l * 128, __builtin_amdgcn_readfirstlane(((const int*)(ws + WS_LAM))[l]), __builtin_bit_cast(int, ap->lam_init[l])};
                  for (int u = vcu; u < 256; u += G) att::attn_unit(u >> 5, u & 31, T, (char*)lds_raw + RING_OFF, lds + RING_OFF, MYTID()); }
                GRID_BAR();
                { KARGS(); pg8::Gemm g{(const pb*)(ws + WS_YA), (const pb*)(ws + WS_WOUT + (size_t)l * SZ_WOUT), SEQ, DM, DM, DM, DM}; pg8::StaticOrder S; S.init(g.M, g.N, G, bx, GEMM_WGM);
                  pg8::EpiResid E{(pb*)(ws + WS_XB), (float*)(ws + WS_SSQ), ap->out, 1.0f, 0};
                  pg8::gemm_phase<pg8::EpiResid, pg8::StaticOrder, true, true>(lds + RING_OFF, g, S, E, MYTID()); }
                GRID_BAR();
            }
        }
    }
}

extern "C" void kernel_launch(void* const* d_in, const int* in_sizes, int n_in, void* d_out, int out_size, void* d_ws, size_t ws_size, hipStream_t stream) {
    static int grid = 0;
    if (grid == 0) {
        if (n_in != 20 || in_sizes[0] != SEQ * DM || out_size != SEQ * DM || ws_size < WS_END) {
            fprintf(stderr, "kernel_launch: shape mismatch: n_in %d in0 %d out %d ws %zu (need >= %zu)\n", n_in, n_in > 0 ? in_sizes[0] : -1, out_size, ws_size, (size_t)WS_END); grid = -1; return; }
        int dev = 0, cus = 0, per_cu = 0;
        if (hipGetDevice(&dev) != hipSuccess || hipDeviceGetAttribute(&cus, hipDeviceAttributeMultiprocessorCount, dev) != hipSuccess) { fprintf(stderr, "kernel_launch: device query failed\n"); grid = -1; return; }
        if (hipFuncSetAttribute((const void*)enc_fwd, hipFuncAttributeMaxDynamicSharedMemorySize, LDS_BYTES) != hipSuccess) { fprintf(stderr, "kernel_launch: hipFuncSetAttribute failed\n"); grid = -1; return; }
        if (hipOccupancyMaxActiveBlocksPerMultiprocessor(&per_cu, (const void*)enc_fwd, NWAVES * 64, LDS_BYTES) != hipSuccess || per_cu < 1)
            fprintf(stderr, "kernel_launch: note: occupancy query reports %d workgroups per CU\n", per_cu);
        (void)hipGetLastError();
        grid = cus;
    }
    if (grid < 0) return;
    if (hipMemsetAsync((char*)d_ws + WS_CTL, 0, CTL_ZERO_BYTES, stream) != hipSuccess) { fprintf(stderr, "kernel_launch: memset failed\n"); return; }
    Args a{};
    for (int i = 0; i < 20; ++i) a.in[i] = (const float*)d_in[i];
    a.out = (float*)d_out; a.ws = (unsigned char*)d_ws;
    for (int l = 0; l < DEPTH; ++l) a.lam_init[l] = (float)(0.8 - 0.6 * exp(-0.3 * (double)l));
    hipLaunchKernelGGL(enc_fwd, dim3(grid), dim3(NWAVES * 64), LDS_BYTES, stream, a);
    const hipError_t le = hipGetLastError();
    if (le != hipSuccess) fprintf(stderr, "kernel_launch: launch failed: %s\n", hipGetErrorName(le));
}
```
